# Optimizing an MI355X kernel written in HIP

```python
import jax, jax.numpy as jnp
from jax import lax
import numpy as np

D_MODEL = 1024
BATCH = 8
SEQ = 4096
DEPTH = 4

N_MIXERS = 2
N_A = (DEPTH + 1) // 2
N_B = DEPTH // 2
RW_HEAD_DIM = 64
RW_HEADS = D_MODEL // RW_HEAD_DIM
LORA_DECAY = 64
LORA_ICLR = 64
LORA_VRES = 32
LORA_GATE = 160
N_SHIFT = 6
LNX_EPS = 64e-5
SG_CHUNK = 128
SG_WIDTH = 2 * D_MODEL
SG_GROUPS = 16
SG_GROUP_DIM = SG_WIDTH // SG_GROUPS
FFN_HIDDEN = -(-8 * D_MODEL // (3 * 256)) * 256
LN_EPS = 1e-5
ALPHA = (2.0 * DEPTH) ** 0.25
BETA = (8.0 * DEPTH) ** -0.25

kernel_name = "hybrid_rwkv7_chunked_gmlp_deepnorm"


def layer_norm(x, g, b, eps=LN_EPS):
    xf = x.astype(jnp.float32)
    mean = jnp.mean(xf, axis=-1, keepdims=True)
    var = jnp.mean(jnp.square(xf - mean), axis=-1, keepdims=True)
    y = (xf - mean) * lax.rsqrt(var + eps)
    return (y * g.astype(jnp.float32) + b.astype(jnp.float32)).astype(x.dtype)


def wkv7_scan(r, w, k, v, a, b):
    bsz, _, n_heads, n = r.shape

    def step(state, inp):
        r_t, w_t, k_t, v_t, a_t, b_t = inp
        sa = jnp.einsum("bhvk,bhk->bhv", state, a_t)
        state = (state * w_t[:, :, None, :] + sa[..., None] * b_t[:, :, None, :]
                 + v_t[..., None] * k_t[:, :, None, :])
        return state, jnp.einsum("bhvk,bhk->bhv", state, r_t)

    s0 = jnp.zeros((bsz, n_heads, n, n), jnp.float32)
    seq_major = tuple(jnp.swapaxes(z, 0, 1) for z in (r, w, k, v, a, b))
    _, ys = lax.scan(step, s0, seq_major)
    return jnp.swapaxes(ys, 0, 1)


def rwkv7_time_mix(x, v_first, mu, w_rkv, w0, w1, w2, a0, a1, a2, v_res,
                   g1, g2, k_k, k_a, r_k, lnx_g, lnx_b, w_out):
    bsz, t, d = x.shape
    f32 = jnp.float32
    heads = lambda z: z.reshape(bsz, t, RW_HEADS, RW_HEAD_DIM)
    xx = jnp.pad(x, ((0, 0), (1, 0), (0, 0)))[:, :-1] - x
    xr, xw, xk, xv, xa, xg = [x + xx * mu[i] for i in range(N_SHIFT)]
    r, k, v = jnp.einsum("jbtd,jde->jbte", jnp.stack([xr, xk, xv]), w_rkv)
    w_log = -jax.nn.softplus(-(w0 + jnp.tanh(xw @ w1) @ w2)) - 0.5
    decay = jnp.exp(-jnp.exp(w_log.astype(f32)))
    a = jax.nn.sigmoid(a0 + (xa @ a1) @ a2)
    if v_res is None:
        v_first = v
    else:
        v0, v1, v2 = v_res
        v = v + (v_first - v) * jax.nn.sigmoid(v0 + (xv @ v1) @ v2)
    g = jax.nn.sigmoid(xg @ g1) @ g2
    kk = heads(k * k_k).astype(f32)
    kk = kk / jnp.maximum(jnp.sqrt(jnp.sum(kk * kk, axis=-1, keepdims=True)), 1e-12)
    k = k * (1 + (a - 1) * k_a)
    rh, kh, vh, ah = (heads(z).astype(f32) for z in (r, k, v, a))
    y = wkv7_scan(rh, heads(decay), kh, vh, -kk, kk * ah)
    mean = jnp.mean(y, axis=-1, keepdims=True)
    var = jnp.mean(jnp.square(y - mean), axis=-1, keepdims=True)
    y = ((y - mean) * lax.rsqrt(var + LNX_EPS)).reshape(bsz, t, d)
    y = y * lnx_g.astype(f32) + lnx_b.astype(f32)
    bonus = jnp.sum(rh * kh * r_k.astype(f32), axis=-1, keepdims=True) * vh
    out = (y + bonus.reshape(bsz, t, d)) * g.astype(f32)
    return out.astype(x.dtype) @ w_out, v_first


def spatial_gating(x, w_in, b_in, ln_g, ln_b, w_s, b_s, w_out):
    bsz, t, _ = x.shape
    z = jax.nn.gelu(x @ w_in + b_in)
    u, v = jnp.split(z, 2, axis=-1)
    v = layer_norm(v, ln_g, ln_b)
    mask = jnp.tril(jnp.ones((SG_CHUNK, SG_CHUNK), dtype=bool))
    ws = jnp.where(mask[None], w_s, jnp.zeros_like(w_s))
    vc = v.reshape(bsz, t // SG_CHUNK, SG_CHUNK, SG_GROUPS, SG_GROUP_DIM)
    mixed = jnp.einsum("gij,bnjgc->bnigc", ws, vc) + b_s.T[None, None, :, :, None]
    return (u * mixed.reshape(bsz, t, SG_WIDTH)) @ w_out


def swiglu(x, w_gate_up, w_down):
    gate, up = jnp.split(x @ w_gate_up, 2, axis=-1)
    return (jax.nn.silu(gate) * up) @ w_down


def setup_inputs(seed: int = 0) -> dict:
    key = jax.random.key(seed)
    ks = jax.random.split(key, 31)
    D, E, F, C, G = D_MODEL, SG_WIDTH, FFN_HIDDEN, SG_CHUNK, SG_GROUPS
    NV = max(N_A - 1, 0)

    def nrm(k, shape, scale):
        return scale * jax.random.normal(k, shape, jnp.float32)

    return {
        "x": nrm(ks[0], (BATCH, SEQ, D), 1.0),
        "rw_mu": jax.random.uniform(ks[1], (N_A, N_SHIFT, D), jnp.float32),
        "rw_w_rkv": nrm(ks[2], (N_A, 3, D, D), D ** -0.5),
        "rw_w0": jax.random.uniform(ks[3], (N_A, D), jnp.float32, -5.0, 1.0),
        "rw_w1": nrm(ks[4], (N_A, D, LORA_DECAY), D ** -0.5),
        "rw_w2": nrm(ks[5], (N_A, LORA_DECAY, D), 0.1 * LORA_DECAY ** -0.5),
        "rw_a0": nrm(ks[6], (N_A, D), 0.3),
        "rw_a1": nrm(ks[7], (N_A, D, LORA_ICLR), D ** -0.5),
        "rw_a2": nrm(ks[8], (N_A, LORA_ICLR, D), 0.3 * LORA_ICLR ** -0.5),
        "rw_v0": 0.5 + nrm(ks[9], (NV, D), 0.3),
        "rw_v1": nrm(ks[10], (NV, D, LORA_VRES), D ** -0.5),
        "rw_v2": nrm(ks[11], (NV, LORA_VRES, D), 0.3 * LORA_VRES ** -0.5),
        "rw_g1": nrm(ks[12], (N_A, D, LORA_GATE), D ** -0.5),
        "rw_g2": nrm(ks[13], (N_A, LORA_GATE, D), LORA_GATE ** -0.5),
        "rw_k_k": 0.85 + nrm(ks[14], (N_A, D), 0.02),
        "rw_k_a": 1.0 + nrm(ks[15], (N_A, D), 0.02),
        "rw_r_k": nrm(ks[16], (N_A, RW_HEADS, RW_HEAD_DIM), 0.1),
        "rw_lnx_g": 1.0 + nrm(ks[17], (N_A, D), 0.02),
        "rw_lnx_b": nrm(ks[18], (N_A, D), 0.02),
        "rw_w_out": nrm(ks[19], (N_A, D, D), BETA * D ** -0.5),
        "sg_w_in": nrm(ks[20], (N_B, D, 2 * E), D ** -0.5),
        "sg_b_in": nrm(ks[21], (N_B, 2 * E), 0.02),
        "sg_ln_g": 1.0 + nrm(ks[22], (N_B, E), 0.02),
        "sg_ln_b": nrm(ks[23], (N_B, E), 0.02),
        "sg_w_s": nrm(ks[24], (N_B, G, C, C), C ** -0.5),
        "sg_b_s": 1.0 + nrm(ks[25], (N_B, G, C), 0.02),
        "sg_w_out": nrm(ks[26], (N_B, E, D), BETA * E ** -0.5),
        "ff_w_gate_up": nrm(ks[27], (DEPTH, D, 2 * F), D ** -0.5),
        "ff_w_down": nrm(ks[28], (DEPTH, F, D), BETA * F ** -0.5),
        "ln_g": 1.0 + nrm(ks[29], (DEPTH, 2, D), 0.02),
        "ln_b": nrm(ks[30], (DEPTH, 2, D), 0.02),
    }


def reference(x, rw_mu, rw_w_rkv, rw_w0, rw_w1, rw_w2, rw_a0, rw_a1, rw_a2,
              rw_v0, rw_v1, rw_v2, rw_g1, rw_g2, rw_k_k, rw_k_a, rw_r_k,
              rw_lnx_g, rw_lnx_b, rw_w_out, sg_w_in, sg_b_in, sg_ln_g, sg_ln_b,
              sg_w_s, sg_b_s, sg_w_out, ff_w_gate_up, ff_w_down, ln_g, ln_b):
    v_first = None
    for i in range(DEPTH):
        j = i // N_MIXERS
        if i % N_MIXERS == 0:
            v_res = None if j == 0 else (rw_v0[j - 1], rw_v1[j - 1], rw_v2[j - 1])
            h, v_first = rwkv7_time_mix(
                x, v_first, rw_mu[j], rw_w_rkv[j], rw_w0[j], rw_w1[j], rw_w2[j],
                rw_a0[j], rw_a1[j], rw_a2[j], v_res, rw_g1[j], rw_g2[j],
                rw_k_k[j], rw_k_a[j], rw_r_k[j], rw_lnx_g[j], rw_lnx_b[j], rw_w_out[j])
        else:
            h = spatial_gating(x, sg_w_in[j], sg_b_in[j], sg_ln_g[j], sg_ln_b[j],
                               sg_w_s[j], sg_b_s[j], sg_w_out[j])
        x = layer_norm(ALPHA * x + h, ln_g[i, 0], ln_b[i, 0])
        x = layer_norm(ALPHA * x + swiglu(x, ff_w_gate_up[i], ff_w_down[i]),
                       ln_g[i, 1], ln_b[i, 1])
    return x
```

```cpp
#include <hip/hip_runtime.h>
#include <hip/hip_cooperative_groups.h>
#include <cstdio>
namespace cg = cooperative_groups;

namespace pg8 {
#define PG8_LAS __attribute__((address_space(3)))
typedef unsigned short bf16_t;
typedef short bf16x8 __attribute__((ext_vector_type(8)));
typedef float f32x4 __attribute__((ext_vector_type(4)));
typedef unsigned u32x4 __attribute__((ext_vector_type(4)));
constexpr int BM = 256, BK = 64, HALF = 128, HTB = HALF * BK * 2  , STAGE_BYTES = 8 * HTB, NXCD = 8, WGM = 4;

__host__ __device__ __forceinline__ int lds_byte(int r, int c) { const int st = (r >> 4) * 2 + (c >> 5), rr = r & 15, cc = c & 31, ob = rr * 64 + cc * 2; return st * 1024 + (ob ^ (((ob >> 9) & 1) << 5)); }
__host__ __device__ __forceinline__ void stage_rc(int b, int& R, int& C) { const int st = b / 1024, sb = b % 1024, swz = sb ^ (((sb >> 9) & 1) << 5); R = (st >> 1) * 16 + swz / 64; C = (st & 1) * 32 + (swz % 64) / 2; }
__host__ __device__ __forceinline__ int perm32(int rho) { const int n = rho >> 4, i = rho & 15; return 8 * (i >> 2) + 4 * n + (i & 3); }

struct Unit { int pm, pn; };
struct Gemm { const bf16_t* A; const bf16_t* Bt; int M, N, K; };

struct StaticOrder {
    int nM, nN, nwg, G, c, wgm_;
    __host__ __device__ void init(int M, int N, int G_, int c_) { nM = M / BM; nN = N / BM; nwg = nM * nN; G = G_; c = c_; wgm_ = (nN <= 4) ? 8 : WGM; }
    __host__ __device__ bool next(int i, Unit& u) const {
        const long L = (long)i * G + c; if (L >= nwg) return false;
        int wgid = (int)L; { const int q = nwg / NXCD, r = nwg % NXCD, xcd = wgid % NXCD, off = wgid / NXCD; wgid = (xcd < r ? xcd * (q + 1) : r * (q + 1) + (xcd - r) * q) + off; }
        const int wgm = wgm_;
        const int nig = wgm * nN, gid = wgid / nig, fm = gid * wgm, gsz = (nM - fm) < wgm ? (nM - fm) : wgm;
        u.pm = fm + ((wgid % nig) % gsz); u.pn = (wgid % nig) / gsz; return true;
    }
    __device__ __forceinline__ void a_ready(const Unit&) const {}
    __device__ __forceinline__ void done(const Unit&) const {}
};

template <class Epi, class Sched, bool ALIGN_EPI = false, bool SP2 = false>
__device__ __forceinline__ void gemm_phase(PG8_LAS unsigned char* lds, const Gemm g, const Sched& S, const Epi& E) {
    int tid_ = threadIdx.x; asm volatile("" : "+v"(tid_)); const int tid = tid_, wid = __builtin_amdgcn_readfirstlane(tid >> 6), lane = tid & 63, wr = wid >> 2, wc = wid & 3, fr = lane & 15, fq = lane >> 4;
    const int K = g.K, nt = K / BK;
    unsigned voffA[2], voffB[2];
#pragma unroll
    for (int i = 0; i < 2; ++i) { int R, C; stage_rc(tid * 16 + i * 8192, R, C); const int Rb = Epi::PERM ? ((R & ~31) + perm32(R & 31)) : R;
        voffA[i] = (unsigned)(R * K + C) * 2u; voffB[i] = (unsigned)(Rb * K + C) * 2u; }
    const size_t kstep = (size_t)(BK * 2);
    const size_t hstep = (size_t)HALF * K * 2;
    const size_t tstep = 2 * hstep;
    const unsigned ldsw = (unsigned)wid * 1024u;
    const int aoff = lds_byte(wr * 64 + fr, fq * 8), boff = lds_byte(wc * 32 + fr, fq * 8);
#define PG8_SA(b, h) (((b) * 2 + (h)) * HTB)
#define PG8_SB(b, h) ((4 + (b) * 2 + (h)) * HTB)
#define PG8_STAGE(bufoff, gbase, voff) do { _Pragma("unroll") for (int _i = 0; _i < 2; ++_i) \
        __builtin_amdgcn_global_load_lds((const unsigned*)((const char*)(gbase) + (voff)[_i]), (PG8_LAS unsigned*)(lds + (bufoff) + ldsw + _i * 8192), 16, 0, 0); } while (0)
#define PG8_LDA(dst, b, h) do { _Pragma("unroll") for (int m = 0; m < 4; ++m) _Pragma("unroll") for (int k = 0; k < 2; ++k) dst[m][k] = *(const PG8_LAS bf16x8*)(lds + PG8_SA(b, h) + aoff + m * 2048 + k * 1024); } while (0)
#define PG8_LDB(dst, b, h) do { _Pragma("unroll") for (int n = 0; n < 2; ++n) _Pragma("unroll") for (int k = 0; k < 2; ++k) dst[n][k] = *(const PG8_LAS bf16x8*)(lds + PG8_SB(b, h) + boff + n * 2048 + k * 1024); } while (0)
#define PG8_MMA(ai, bj, At, Bt) do { __builtin_amdgcn_s_setprio(1); _Pragma("unroll") for (int m = 0; m < 4; ++m) _Pragma("unroll") for (int n = 0; n < 2; ++n) _Pragma("unroll") for (int k = 0; k < 2; ++k) \
        acc[ai][bj][m][n] = __builtin_amdgcn_mfma_f32_16x16x32_bf16(Bt[n][k], At[m][k], acc[ai][bj][m][n], 0, 0, 0); __builtin_amdgcn_s_setprio(0); } while (0)
#define PG8_WAIT_V(n) asm volatile("s_waitcnt vmcnt(" #n ")" ::: "memory")
#define PG8_WAIT_L(n) asm volatile("s_waitcnt lgkmcnt(" #n ")" ::: "memory")
#define PG8_BAR __builtin_amdgcn_s_barrier()
#define PG8_SCHED __builtin_amdgcn_sched_barrier(0)
    Unit cur, nxt; int ui = 0;
    if (!S.next(0, cur)) return;
    f32x4 acc[2][2][4][2];
#pragma unroll
    for (int a = 0; a < 2; ++a)
#pragma unroll
        for (int b = 0; b < 2; ++b)
#pragma unroll
            for (int m = 0; m < 4; ++m)
#pragma unroll
                for (int n = 0; n < 2; ++n) acc[a][b][m][n] = (f32x4){0.f, 0.f, 0.f, 0.f};
    bf16x8 At[4][2], B0[2][2], B1[2][2];
    const char* cA = (const char*)g.A + (size_t)cur.pm * tstep; const char* cB = (const char*)g.Bt + (size_t)cur.pn * tstep;
    S.a_ready(cur);
    if constexpr (SP2) {
        PG8_STAGE(PG8_SB(0, 0), cB, voffB); PG8_STAGE(PG8_SB(0, 1), cB + hstep, voffB); PG8_STAGE(PG8_SA(0, 0), cA, voffA); PG8_STAGE(PG8_SA(0, 1), cA + hstep, voffA);
        if (wr == 1) PG8_BAR;
        PG8_WAIT_V(2); PG8_BAR;
        PG8_STAGE(PG8_SB(1, 0), cB + kstep, voffB); PG8_STAGE(PG8_SA(1, 0), cA + kstep, voffA); PG8_STAGE(PG8_SB(1, 1), cB + hstep + kstep, voffB);
        PG8_WAIT_V(6); PG8_BAR;
    } else {
        PG8_STAGE(PG8_SB(0, 0), cB, voffB); PG8_STAGE(PG8_SA(0, 0), cA, voffA); PG8_STAGE(PG8_SB(0, 1), cB + hstep, voffB); PG8_STAGE(PG8_SA(0, 1), cA + hstep, voffA);
        if (wr == 1) PG8_BAR;
        PG8_WAIT_V(4); PG8_BAR;
        PG8_STAGE(PG8_SB(1, 0), cB + kstep, voffB); PG8_STAGE(PG8_SA(1, 0), cA + kstep, voffA); PG8_STAGE(PG8_SB(1, 1), cB + hstep + kstep, voffB);
        PG8_WAIT_V(6); PG8_BAR;
    }
    for (;;) {
        const bool has_next = S.next(ui + 1, nxt);
        const char* nA = has_next ? (const char*)g.A + (size_t)nxt.pm * tstep : cA; const char* nB = has_next ? (const char*)g.Bt + (size_t)nxt.pn * tstep : cB;
        for (int t = 0; t < nt; t += 2) {
            const bool last = (t == nt - 2);
            const char* a1 = cA + (size_t)(t + 1) * kstep;
            const char* a2 = last ? nA : cA + (size_t)(t + 2) * kstep; const char* b2 = last ? nB : cB + (size_t)(t + 2) * kstep;
            const char* a3 = a2 + kstep; const char* b3 = b2 + kstep;
            if (last && has_next) S.a_ready(nxt);
            if constexpr (SP2) {
            PG8_LDB(B0, 0, 0); PG8_LDB(B1, 0, 1); PG8_SCHED; PG8_LDA(At, 0, 0); PG8_STAGE(PG8_SA(1, 1), a1 + hstep, voffA);
            PG8_WAIT_V(8); PG8_WAIT_L(0); PG8_BAR; PG8_MMA(0, 0, At, B0); PG8_MMA(0, 1, At, B1); PG8_BAR; PG8_SCHED;
            PG8_LDA(At, 0, 1); PG8_STAGE(PG8_SB(0, 0), b2, voffB); PG8_STAGE(PG8_SB(0, 1), b2 + hstep, voffB); PG8_STAGE(PG8_SA(0, 0), a2, voffA);
            PG8_WAIT_V(8); PG8_WAIT_L(0); PG8_BAR; PG8_MMA(1, 0, At, B0); PG8_MMA(1, 1, At, B1); PG8_BAR; PG8_SCHED;
            PG8_LDB(B0, 1, 0); PG8_LDB(B1, 1, 1); PG8_SCHED; PG8_LDA(At, 1, 0); PG8_STAGE(PG8_SA(0, 1), a2 + hstep, voffA);
            PG8_WAIT_V(8); PG8_WAIT_L(0); PG8_BAR; PG8_MMA(0, 0, At, B0); PG8_MMA(0, 1, At, B1); PG8_BAR; PG8_SCHED;
            PG8_LDA(At, 1, 1); PG8_STAGE(PG8_SB(1, 0), b3, voffB); PG8_STAGE(PG8_SB(1, 1), b3 + hstep, voffB); PG8_STAGE(PG8_SA(1, 0), a3, voffA);
            PG8_WAIT_V(8); PG8_WAIT_L(0); PG8_BAR; PG8_MMA(1, 0, At, B0); PG8_MMA(1, 1, At, B1); PG8_BAR; PG8_SCHED;
            } else {
            PG8_LDB(B0, 0, 0); PG8_SCHED; PG8_LDA(At, 0, 0); PG8_STAGE(PG8_SA(1, 1), a1 + hstep, voffA);
            PG8_WAIT_L(8); PG8_BAR; PG8_WAIT_L(0); PG8_MMA(0, 0, At, B0); PG8_BAR; PG8_SCHED;
            PG8_LDB(B1, 0, 1); PG8_STAGE(PG8_SB(0, 0), b2, voffB);
            PG8_BAR; PG8_WAIT_L(0); PG8_MMA(0, 1, At, B1); PG8_BAR;
            PG8_LDA(At, 0, 1); PG8_STAGE(PG8_SA(0, 0), a2, voffA);
            PG8_BAR; PG8_WAIT_L(0); PG8_MMA(1, 0, At, B0); PG8_BAR; PG8_SCHED;
            PG8_STAGE(PG8_SB(0, 1), b2 + hstep, voffB);
            PG8_WAIT_V(6); PG8_BAR; PG8_MMA(1, 1, At, B1); PG8_BAR;
            PG8_LDB(B0, 1, 0); PG8_SCHED; PG8_LDA(At, 1, 0); PG8_STAGE(PG8_SA(0, 1), a2 + hstep, voffA);
            PG8_WAIT_L(8); PG8_BAR; PG8_WAIT_L(0); PG8_MMA(0, 0, At, B0); PG8_BAR; PG8_SCHED;
            PG8_LDB(B1, 1, 1); PG8_STAGE(PG8_SB(1, 0), b3, voffB);
            PG8_BAR; PG8_WAIT_L(0); PG8_MMA(0, 1, At, B1); PG8_BAR;
            PG8_LDA(At, 1, 1); PG8_STAGE(PG8_SA(1, 0), a3, voffA);
            PG8_BAR; PG8_WAIT_L(0); PG8_MMA(1, 0, At, B0); PG8_BAR; PG8_SCHED;
            PG8_STAGE(PG8_SB(1, 1), b3 + hstep, voffB);
            PG8_WAIT_V(6); PG8_BAR; PG8_MMA(1, 1, At, B1); PG8_BAR;
            }
        }
        if constexpr (ALIGN_EPI) { if (wr == 0) PG8_BAR; }
        if constexpr (!Epi::AFTER_DRAIN) { E(acc, cur, wr, wc, fr, fq); S.done(cur); }
        if (!has_next) break;
#pragma unroll
        for (int a = 0; a < 2; ++a)
#pragma unroll
            for (int b = 0; b < 2; ++b)
#pragma unroll
                for (int m = 0; m < 4; ++m)
#pragma unroll
                    for (int n = 0; n < 2; ++n) acc[a][b][m][n] = (f32x4){0.f, 0.f, 0.f, 0.f};
        cur = nxt; cA = nA; cB = nB; ++ui;
        if constexpr (ALIGN_EPI) { if (wr == 1) PG8_BAR; }
    }
    PG8_WAIT_V(0);
    if constexpr (!ALIGN_EPI) { if (wr == 0) PG8_BAR; }
    PG8_BAR;
    if constexpr (Epi::AFTER_DRAIN) { E.fused(acc, cur, wr, wc, fr, fq, lds, wid, lane); S.done(cur); }
#undef PG8_SA
#undef PG8_SB
#undef PG8_STAGE
#undef PG8_LDA
#undef PG8_LDB
#undef PG8_MMA
#undef PG8_WAIT_V
#undef PG8_WAIT_L
#undef PG8_BAR
#undef PG8_SCHED
}
typedef float f32x2_t __attribute__((ext_vector_type(2)));
typedef __bf16 bf16x2_t __attribute__((ext_vector_type(2)));
__device__ __forceinline__ unsigned cvt_pk_bf16(float lo, float hi) { f32x2_t v = {lo, hi}; bf16x2_t b = __builtin_convertvector(v, bf16x2_t); return __builtin_bit_cast(unsigned, b); }
__device__ __forceinline__ float fast_rcp(float x) { return __builtin_amdgcn_rcpf(x); }
__device__ __forceinline__ float sigmoidf_(float x) { return fast_rcp(1.0f + __expf(-x)); }
__device__ __forceinline__ float gelu_tanh(float x) { const float t = x * __builtin_fmaf(x * x, -0.10294324f, -2.3022082f);
    return x * fast_rcp(1.0f + __builtin_amdgcn_exp2f(t)); }

template <int ACT  > struct EpiBf16 {
    static constexpr bool PERM = true, AFTER_DRAIN = false;
    bf16_t* O; int ldc; const float* bias; int split_cols; size_t split_stride;
    __device__ __forceinline__ void operator()(const f32x4 (&acc)[2][2][4][2], const Unit& u, int wr, int wc, int fr, int fq) const {
        const int row0 = u.pm * BM + wr * 64 + fr; int colt = u.pn * BM; bf16_t* base = O;
        if (split_cols) { const int t = colt / split_cols; base += (size_t)t * split_stride; colt -= t * split_cols; }
        const int col0 = colt + wc * 32 + 8 * fq, bcol0 = u.pn * BM + wc * 32 + 8 * fq;
        f32x4 bv[2][2];
#pragma unroll
        for (int bj = 0; bj < 2; ++bj)
#pragma unroll
            for (int n = 0; n < 2; ++n) bv[bj][n] = (ACT == 1) ? *(const f32x4*)(bias + bcol0 + bj * HALF + 4 * n) : (f32x4){0.f, 0.f, 0.f, 0.f};
#pragma unroll
        for (int ai = 0; ai < 2; ++ai)
#pragma unroll
            for (int m = 0; m < 4; ++m) { bf16_t* rowp = base + (size_t)(row0 + ai * HALF + m * 16) * ldc + col0;
#pragma unroll
                for (int bj = 0; bj < 2; ++bj) { f32x4 v0 = acc[ai][bj][m][0] + bv[bj][0], v1 = acc[ai][bj][m][1] + bv[bj][1];
                    if (ACT == 1) {
#pragma unroll
                        for (int j = 0; j < 4; ++j) { v0[j] = gelu_tanh(v0[j]); v1[j] = gelu_tanh(v1[j]); } }
                    u32x4 w; w.x = cvt_pk_bf16(v0[0], v0[1]); w.y = cvt_pk_bf16(v0[2], v0[3]); w.z = cvt_pk_bf16(v1[0], v1[1]); w.w = cvt_pk_bf16(v1[2], v1[3]);
                    *(u32x4*)(rowp + bj * HALF) = w; } }
    }
};
struct EpiSwiglu {
    static constexpr bool PERM = true, AFTER_DRAIN = false;
    bf16_t* O; int ldc;
    __device__ __forceinline__ void operator()(const f32x4 (&acc)[2][2][4][2], const Unit& u, int wr, int wc, int fr, int fq) const {
        const int row0 = u.pm * BM + wr * 64 + fr, col0 = u.pn * HALF + wc * 32 + 8 * fq;
#pragma unroll
        for (int ai = 0; ai < 2; ++ai)
#pragma unroll
            for (int m = 0; m < 4; ++m) { bf16_t* rowp = O + (size_t)(row0 + ai * HALF + m * 16) * ldc + col0;
                f32x4 v0, v1;
#pragma unroll
                for (int j = 0; j < 4; ++j) { const float g0 = acc[ai][0][m][0][j], g1 = acc[ai][0][m][1][j];
                    v0[j] = g0 * acc[ai][1][m][0][j] * fast_rcp(1.0f + __builtin_amdgcn_exp2f(g0 * -1.4426950408889634f));
                    v1[j] = g1 * acc[ai][1][m][1][j] * fast_rcp(1.0f + __builtin_amdgcn_exp2f(g1 * -1.4426950408889634f)); }
                u32x4 w; w.x = cvt_pk_bf16(v0[0], v0[1]); w.y = cvt_pk_bf16(v0[2], v0[3]); w.z = cvt_pk_bf16(v1[0], v1[1]); w.w = cvt_pk_bf16(v1[2], v1[3]);
                *(u32x4*)rowp = w; }
    }
};
struct EpiResid {
    static constexpr bool PERM = false, AFTER_DRAIN = false;
    const float* in; const float* st; const float* g; const float* b; float* out; int ldc; float alpha;
    __device__ __forceinline__ void operator()(const f32x4 (&acc)[2][2][4][2], const Unit& u, int wr, int wc, int fr, int fq) const {
        const int row0 = u.pm * BM + wr * 64 + fr, col0 = u.pn * BM + wc * 32 + 4 * fq;
        f32x4 gv[2][2], bv[2][2];
        if (st) {
#pragma unroll
            for (int bj = 0; bj < 2; ++bj)
#pragma unroll
                for (int n = 0; n < 2; ++n) { gv[bj][n] = *(const f32x4*)(g + col0 + bj * HALF + n * 16); bv[bj][n] = *(const f32x4*)(b + col0 + bj * HALF + n * 16); } }
#pragma unroll
        for (int ai = 0; ai < 2; ++ai)
#pragma unroll
            for (int m = 0; m < 4; ++m) { const int row = row0 + ai * HALF + m * 16; const size_t off = (size_t)row * ldc + col0;
                float mean = 0.f, rstd = 1.f;
                if (st) { mean = st[2 * row]; rstd = st[2 * row + 1]; }
#pragma unroll
                for (int bj = 0; bj < 2; ++bj)
#pragma unroll
                    for (int n = 0; n < 2; ++n) { f32x4 x = *(const f32x4*)(in + off + bj * HALF + n * 16);
                        if (st) x = (x - mean) * rstd * gv[bj][n] + bv[bj][n];
                        *(f32x4*)(out + off + bj * HALF + n * 16) = x * alpha + acc[ai][bj][m][n]; } }
    }
};
}

typedef unsigned short bf16_t;
typedef short bf16x8 __attribute__((ext_vector_type(8)));
typedef float f32x4 __attribute__((ext_vector_type(4)));
typedef unsigned u32x4 __attribute__((ext_vector_type(4)));
typedef unsigned u32x2 __attribute__((ext_vector_type(2)));
#define LAS __attribute__((address_space(3)))
constexpr int DM = 1024, NB = 8, TS = 4096, MT = NB * TS, FF = 2816, EW = 2048;
constexpr float LN_EPS = 1e-5f, LNX_EPS = 64e-5f, ALPHA = 1.6817928305074290f;
constexpr int NWAVES = 8, NTHREADS = 512, LDS_BYTES = 147456;
constexpr size_t MiB = 1u << 20, M1 = 1u << 20;
constexpr size_t WS_W = 0, WS_VF = 120 * MiB, WS_XB = 184 * MiB, WS_BIG = 248 * MiB, WS_RK = 504 * MiB, WS_CTL = 508 * MiB, WS_ST = 509 * MiB, WS_END = 510 * MiB;
constexpr size_t WA_SZ = 4 * M1 + 2 * 327680, WA_RKV = 0, WA_OUT = 3 * M1, WA_L1T = 4 * M1, WA_L2W = WA_L1T + 327680, WA_L2A = WA_L2W + 65536, WA_L2V = WA_L2A + 65536, WA_L2G = WA_L2V + 32768;
constexpr size_t WB_OFF = 2 * WA_SZ, WB_SZ = 6 * M1 + 262144, WB_IN = 0, WB_OUT = 4 * M1, WB_WS = 6 * M1;
constexpr size_t WF_OFF = WB_OFF + 2 * WB_SZ, WF_GU = 0, WF_DN = (size_t)5632 * 1024, WF_SZ = WF_DN + (size_t)1024 * 2816;
static_assert((WF_OFF + 4 * WF_SZ) * 2 <= WS_VF, "weights fit");
constexpr size_t BIG_R = 0, BIG_K = 64 * MiB, BIG_V = 128 * MiB, BIG_LH = 192 * MiB, BIG_U = 0, BIG_VG = 128 * MiB, BIG_H = 0;

__device__ __forceinline__ unsigned pk2(float lo, float hi) { return pg8::cvt_pk_bf16(lo, hi); }
__device__ __forceinline__ float bf_lo(unsigned u) { return __uint_as_float(u << 16); }
__device__ __forceinline__ float bf_hi(unsigned u) { return __uint_as_float(u & 0xffff0000u); }
__device__ __forceinline__ f32x4 unpack4(u32x2 u) { return (f32x4){bf_lo(u.x), bf_hi(u.x), bf_lo(u.y), bf_hi(u.y)}; }
__device__ __forceinline__ u32x2 pack4(f32x4 v) { u32x2 r; r.x = pk2(v[0], v[1]); r.y = pk2(v[2], v[3]); return r; }
__device__ __forceinline__ bf16x8 pack8(f32x4 a, f32x4 b) { u32x4 w; w.x = pk2(a[0], a[1]); w.y = pk2(a[2], a[3]); w.z = pk2(b[0], b[1]); w.w = pk2(b[2], b[3]); return __builtin_bit_cast(bf16x8, w); }
__device__ __forceinline__ float wave_sum(float v) {
#pragma unroll
    for (int o = 1; o < 64; o <<= 1) v += __shfl_xor(v, o);
    return v;
}
using pg8::sigmoidf_;
__device__ __forceinline__ float tanhf_(float x) { return 1.0f - 2.0f * pg8::fast_rcp(1.0f + __expf(2.0f * x)); }
#define MFMA16(a, b, c) __builtin_amdgcn_mfma_f32_16x16x32_bf16((a), (b), (c), 0, 0, 0)

__device__ __forceinline__ void transpose_item(const float* W, int K, int N, bf16_t* WT, int mode, LAS float* scr, int item, int lane) {
    const int nblk = N / 32, kb = item / nblk, nb = item % nblk, k0 = 64 * kb, n0 = 32 * nb;
    int d0 = n0;
    if (mode == 1) { d0 = (n0 < FF) ? (256 * (n0 / 128) + (n0 % 128)) : (256 * ((n0 - FF) / 128) + 128 + ((n0 - FF) % 128)); }
#pragma unroll 8
    for (int i = 0; i < 32; ++i) { const int kk = 2 * i + (lane >> 5); scr[kk * 33 + (lane & 31)] = W[(size_t)(k0 + kk) * N + n0 + (lane & 31)]; }
    asm volatile("s_waitcnt lgkmcnt(0)" ::: "memory");
    const int c = lane & 7;
#pragma unroll
    for (int j = 0; j < 4; ++j) { const int n = (lane >> 3) + 8 * j; const LAS float* s = scr + (8 * c) * 33 + n;
        u32x4 o; o.x = pk2(s[0 * 33], s[1 * 33]); o.y = pk2(s[2 * 33], s[3 * 33]); o.z = pk2(s[4 * 33], s[5 * 33]); o.w = pk2(s[6 * 33], s[7 * 33]);
        *(u32x4*)(WT + (size_t)(d0 + n) * K + k0 + 8 * c) = o; }
    asm volatile("s_waitcnt lgkmcnt(0)" ::: "memory");
}
__device__ __forceinline__ void conv_big(const float* W, int K, int N, bf16_t* WT, int mode, LAS float* scr, int gw, int NGW, int& rot, int lane) {
    const int nitems = (K / 64) * (N / 32);
    int start = gw - (rot % NGW); if (start < 0) start += NGW;
    for (int it = start; it < nitems; it += NGW) transpose_item(W, K, N, WT, mode, scr, it, lane);
    rot += nitems;
}
struct In { const float* p[31]; };
__device__ __forceinline__ void phase_convert(const In& in, bf16_t* Wb, LAS unsigned char* lds) {
    int tid_ = threadIdx.x; asm volatile("" : "+v"(tid_)); const int tid = tid_, lane = tid & 63, wave = tid >> 6, gw = blockIdx.x * NWAVES + wave, NGW = gridDim.x * NWAVES;
    LAS float* scr = (LAS float*)(lds + wave * 16384);
    int rot = 0;
    for (int j = 0; j < 2; ++j) {
        for (int c = 0; c < 3; ++c) conv_big(in.p[2] + (size_t)(j * 3 + c) * M1, 1024, 1024, Wb + j * WA_SZ + WA_RKV + c * M1, 0, scr, gw, NGW, rot, lane);
        conv_big(in.p[19] + (size_t)j * M1, 1024, 1024, Wb + j * WA_SZ + WA_OUT, 0, scr, gw, NGW, rot, lane);
        conv_big(in.p[20] + (size_t)j * 4 * M1, 1024, 4096, Wb + WB_OFF + j * WB_SZ + WB_IN, 0, scr, gw, NGW, rot, lane);
        conv_big(in.p[26] + (size_t)j * 2 * M1, 2048, 1024, Wb + WB_OFF + j * WB_SZ + WB_OUT, 0, scr, gw, NGW, rot, lane);
    }
    for (int i = 0; i < 4; ++i) {
        conv_big(in.p[27] + (size_t)i * 1024 * 5632, 1024, 5632, Wb + WF_OFF + i * WF_SZ + WF_GU, 1, scr, gw, NGW, rot, lane);
        conv_big(in.p[28] + (size_t)i * 2816 * 1024, 2816, 1024, Wb + WF_OFF + i * WF_SZ + WF_DN, 0, scr, gw, NGW, rot, lane);
    }
    const int gt = blockIdx.x * NTHREADS + tid, NGT = gridDim.x * NTHREADS;
    for (int j = 0; j < 2; ++j) {
        bf16_t* L1T = Wb + j * WA_SZ + WA_L1T;
        for (int e = gt; e < 320 * 1024; e += NGT) { const int n = e >> 10, k = e & 1023; float v;
            if (n < 64) v = in.p[4][((size_t)j * 1024 + k) * 64 + n];
            else if (n < 128) v = in.p[7][((size_t)j * 1024 + k) * 64 + (n - 64)];
            else if (n < 160) v = (j > 0) ? in.p[10][((size_t)(j - 1) * 1024 + k) * 32 + (n - 128)] : 0.f;
            else v = in.p[12][((size_t)j * 1024 + k) * 160 + (n - 160)];
            L1T[(size_t)(k >> 5) * 10240 + n * 32 + (k & 31)] = (bf16_t)(pk2(v, 0.f) & 0xffffu); }
        bf16_t* L2W = Wb + j * WA_SZ + WA_L2W; bf16_t* L2A = Wb + j * WA_SZ + WA_L2A; bf16_t* L2V = Wb + j * WA_SZ + WA_L2V; bf16_t* L2G = Wb + j * WA_SZ + WA_L2G;
        for (int e = gt; e < 1024 * 64; e += NGT) { const int ch = e >> 6, k = e & 63;
            L2W[e] = (bf16_t)(pk2(in.p[5][((size_t)j * 64 + k) * 1024 + ch], 0.f) & 0xffffu);
            L2A[e] = (bf16_t)(pk2(in.p[8][((size_t)j * 64 + k) * 1024 + ch], 0.f) & 0xffffu); }
        for (int e = gt; e < 1024 * 32; e += NGT) { const int ch = e >> 5, k = e & 31;
            L2V[e] = (bf16_t)(pk2((j > 0) ? in.p[11][((size_t)(j - 1) * 32 + k) * 1024 + ch] : 0.f, 0.f) & 0xffffu); }
        for (int e = gt; e < 1024 * 160; e += NGT) { const int ch = e / 160, k = e % 160;
            L2G[e] = (bf16_t)(pk2(in.p[13][((size_t)j * 160 + k) * 1024 + ch], 0.f) & 0xffffu); }
        bf16_t* WSM = Wb + WB_OFF + j * WB_SZ + WB_WS;
        for (int e = gt; e < 16 * 128 * 128; e += NGT) { const int i = (e >> 7) & 127, jj = e & 127;
            WSM[e] = (bf16_t)(pk2((jj <= i) ? in.p[24][(size_t)j * 262144 + e] : 0.f, 0.f) & 0xffffu); }
    }
}

constexpr int P0_ROWB = 80, P0_SLAB = 320 * P0_ROWB;
__device__ __forceinline__ void phase_prep0(LAS unsigned char* lds, const float* xin, const float* mu, const bf16_t* L1S, bf16_t* XR, bf16_t* XK, bf16_t* XV, bf16_t* LH, bool has_v) {
    int tid_ = threadIdx.x; asm volatile("" : "+v"(tid_)); const int tid = tid_, lane = tid & 63, wave = tid >> 6, fr = lane & 15, fq = lane >> 4;
    LAS float* mus = (LAS float*)lds;
    LAS unsigned char* wb = lds + 24576;
    for (int e = tid; e < 6 * DM / 4; e += NTHREADS) *(LAS f32x4*)(mus + 4 * e) = *(const f32x4*)(mu + 4 * e);
    for (int blk = ((gridDim.x == 256) ? (int)((blockIdx.x & 7) * 32 + (blockIdx.x >> 3)) : (int)blockIdx.x); blk < MT / 128; blk += gridDim.x) {
        const int tok = blk * 128 + wave * 16 + fr; const bool first = (tok % TS) == 0;
        const float* xrow = xin + (size_t)tok * DM; const float* prow = xrow - DM;
        u32x4 wreg[3];
#pragma unroll
        for (int i = 0; i < 3; ++i) { const int q = tid + 512 * i; if (q < 1280) wreg[i] = *(const u32x4*)(L1S + (size_t)q * 8); }
#pragma unroll
        for (int i = 0; i < 3; ++i) { const int q = tid + 512 * i; if (q < 1280) *(LAS u32x4*)(wb + (q >> 2) * P0_ROWB + (q & 3) * 16) = wreg[i]; }
        __syncthreads();
        f32x4 acc[20];
#pragma unroll
        for (int j = 0; j < 20; ++j) acc[j] = (f32x4){0.f, 0.f, 0.f, 0.f};
        f32x4 nx0 = *(const f32x4*)(xrow + 8 * fq), nx1 = *(const f32x4*)(xrow + 8 * fq + 4), np0 = (f32x4){0.f, 0.f, 0.f, 0.f}, np1 = np0;
        if (!first) { np0 = *(const f32x4*)(prow + 8 * fq); np1 = *(const f32x4*)(prow + 8 * fq + 4); }
#pragma unroll 1
        for (int s = 0; s < 32; ++s) {
            const int c0 = 32 * s + 8 * fq;
            if (s + 1 < 32) {
#pragma unroll
                for (int i = 0; i < 3; ++i) { const int q = tid + 512 * i; if (q < 1280) wreg[i] = *(const u32x4*)(L1S + (size_t)(s + 1) * 10240 + (size_t)q * 8); } }
            const f32x4 x0 = nx0, x1 = nx1; f32x4 d0 = np0 - x0, d1 = np1 - x1;
            if (s + 1 < 32) { nx0 = *(const f32x4*)(xrow + c0 + 32); nx1 = *(const f32x4*)(xrow + c0 + 36);
                if (!first) { np0 = *(const f32x4*)(prow + c0 + 32); np1 = *(const f32x4*)(prow + c0 + 36); } }
#define MUV(i, o) (*(const LAS f32x4*)(mus + (i) * DM + c0 + (o)))
            *(bf16x8*)(XR + (size_t)tok * DM + c0) = pack8(x0 + d0 * MUV(0, 0), x1 + d1 * MUV(0, 4));
            *(bf16x8*)(XK + (size_t)tok * DM + c0) = pack8(x0 + d0 * MUV(2, 0), x1 + d1 * MUV(2, 4));
            const bf16x8 xw = pack8(x0 + d0 * MUV(1, 0), x1 + d1 * MUV(1, 4));
            const bf16x8 xv = pack8(x0 + d0 * MUV(3, 0), x1 + d1 * MUV(3, 4));
            if (XV) *(bf16x8*)(XV + (size_t)tok * DM + c0) = xv;
            const bf16x8 xa = pack8(x0 + d0 * MUV(4, 0), x1 + d1 * MUV(4, 4));
            const bf16x8 xg = pack8(x0 + d0 * MUV(5, 0), x1 + d1 * MUV(5, 4));
#undef MUV
            const LAS unsigned char* wsl = wb + (s & 1) * P0_SLAB + fr * P0_ROWB + fq * 16;
#pragma unroll
            for (int j = 0; j < 20; ++j) {
                if (has_v || (j != 8 && j != 9)) {
                    const bf16x8 wf = *(const LAS bf16x8*)(wsl + 16 * j * P0_ROWB);
                    acc[j] = MFMA16(wf, (j < 4) ? xw : (j < 8) ? xa : (j < 10) ? xv : xg, acc[j]);
                }
            }
            if (s + 1 < 32) {
#pragma unroll
                for (int i = 0; i < 3; ++i) { const int q = tid + 512 * i; if (q < 1280) *(LAS u32x4*)(wb + ((s + 1) & 1) * P0_SLAB + (q >> 2) * P0_ROWB + (q & 3) * 16) = wreg[i]; } }
            __syncthreads();
        }
#pragma unroll
        for (int j = 0; j < 20; ++j) { f32x4 v = acc[j];
            if (j < 4) { v[0] = tanhf_(v[0]); v[1] = tanhf_(v[1]); v[2] = tanhf_(v[2]); v[3] = tanhf_(v[3]); }
            if (j >= 10) { v[0] = sigmoidf_(v[0]); v[1] = sigmoidf_(v[1]); v[2] = sigmoidf_(v[2]); v[3] = sigmoidf_(v[3]); }
            *(u32x2*)(LH + (size_t)tok * 320 + 16 * j + 4 * fq) = pack4(v); }
    }
}
__device__ __forceinline__ void phase_shift(const float* xin, const float* mu, bf16_t* dst) {
    int tid_ = threadIdx.x; asm volatile("" : "+v"(tid_)); const int gt = blockIdx.x * NTHREADS + tid_, NGT = gridDim.x * NTHREADS;
    for (int i = gt; i < MT * 128; i += NGT) { const int tok = i >> 7, c0 = (i & 127) * 8;
        const float* xrow = xin + (size_t)tok * DM + c0;
        const f32x4 x0 = *(const f32x4*)xrow, x1 = *(const f32x4*)(xrow + 4);
        f32x4 d0 = (f32x4){0.f, 0.f, 0.f, 0.f}, d1 = d0;
        if ((tok % TS) != 0) { d0 = *(const f32x4*)(xrow - DM); d1 = *(const f32x4*)(xrow - DM + 4); }
        d0 = d0 - x0; d1 = d1 - x1;
        *(bf16x8*)(dst + (size_t)tok * DM + c0) = pack8(x0 + d0 * *(const f32x4*)(mu + c0), x1 + d1 * *(const f32x4*)(mu + c0 + 4)); }
}

__device__ __forceinline__ void phase_ln(const float* pre, const float* g, const float* b, float* xf, bf16_t* xb, float* stats) {
    int tid_ = threadIdx.x; asm volatile("" : "+v"(tid_)); const int tid = tid_, lane = tid & 63, wave = tid >> 6, gw = blockIdx.x * NWAVES + wave, NGW = gridDim.x * NWAVES;
    f32x4 gv[4], bv[4];
#pragma unroll
    for (int j = 0; j < 4; ++j) { gv[j] = *(const f32x4*)(g + 4 * lane + 256 * j); bv[j] = *(const f32x4*)(b + 4 * lane + 256 * j); }
    for (int row = gw; row < MT; row += NGW) {
        const float* xr = pre + (size_t)row * DM + 4 * lane;
        f32x4 v[4]; float s = 0.f;
#pragma unroll
        for (int j = 0; j < 4; ++j) { v[j] = *(const f32x4*)(xr + 256 * j); s += (v[j][0] + v[j][1]) + (v[j][2] + v[j][3]); }
        const float mean = wave_sum(s) * (1.f / DM); float s2 = 0.f;
#pragma unroll
        for (int j = 0; j < 4; ++j) { v[j] = v[j] - mean; s2 += (v[j][0] * v[j][0] + v[j][1] * v[j][1]) + (v[j][2] * v[j][2] + v[j][3] * v[j][3]); }
        const float rstd = __builtin_amdgcn_rsqf(wave_sum(s2) * (1.f / DM) + LN_EPS);
        if (stats && lane == 0) { stats[2 * row] = mean; stats[2 * row + 1] = rstd; }
#pragma unroll
        for (int j = 0; j < 4; ++j) { const f32x4 o = v[j] * rstd * gv[j] + bv[j];
            if (xf) *(f32x4*)(xf + (size_t)row * DM + 4 * lane + 256 * j) = o;
            if (xb) *(u32x2*)(xb + (size_t)row * DM + 4 * lane + 256 * j) = pack4(o); }
    }
}
constexpr int SC_TC = 32, SC_STEP = 356, SC_BUF = SC_TC * SC_STEP;
struct ScanP { const bf16_t* R; const bf16_t* K; bf16_t* V; const bf16_t* VF; const bf16_t* LH; const bf16_t* L2W; const bf16_t* L2A; const bf16_t* L2V;
               const float* w0; const float* a0; const float* v0; const float* k_k; const float* k_a; const float* r_k; bf16_t* Y; float* RK; };
__device__ __forceinline__ float red8(float x) {
    x += __int_as_float(__builtin_amdgcn_update_dpp(0, __float_as_int(x), 0xB1, 0xf, 0xf, true));
    x += __int_as_float(__builtin_amdgcn_update_dpp(0, __float_as_int(x), 0x4E, 0xf, 0xf, true));
    x += __int_as_float(__builtin_amdgcn_update_dpp(0, __float_as_int(x), 0x141, 0xf, 0xf, true));
    return x;
}
__device__ __forceinline__ void scan_produce(const ScanP& P, LAS float* buf, int tok, int srow, int h, int half, int cp, int fr, int fq, bool has_v) {
    const bf16_t* lh = P.LH + (size_t)tok * 320 + 8 * fq;
    const bf16x8 xw0 = *(const bf16x8*)(lh), xw1 = *(const bf16x8*)(lh + 32), xa0 = *(const bf16x8*)(lh + 64), xa1 = *(const bf16x8*)(lh + 96);
    float ss = 0.f, rk = 0.f; f32x4 kkq[2], bqq[2];
    const f32x4 z4 = (f32x4){0.f, 0.f, 0.f, 0.f};
    const bool own = cp == half;
    LAS float* p = buf + srow * SC_STEP + 4 * fq;
#pragma unroll
    for (int cc = 0; cc < 2; ++cc) {
        const int ct = 2 * cp + cc;
        const int crow = 64 * h + 16 * ct + fr, c = 64 * h + 16 * ct + 4 * fq;
        f32x4 aw = MFMA16(*(const bf16x8*)(P.L2W + (size_t)crow * 64 + 8 * fq), xw0, z4); aw = MFMA16(*(const bf16x8*)(P.L2W + (size_t)crow * 64 + 32 + 8 * fq), xw1, aw);
        f32x4 aa = MFMA16(*(const bf16x8*)(P.L2A + (size_t)crow * 64 + 8 * fq), xa0, z4); aa = MFMA16(*(const bf16x8*)(P.L2A + (size_t)crow * 64 + 32 + 8 * fq), xa1, aa);
        const f32x4 w0v = *(const f32x4*)(P.w0 + c), a0v = *(const f32x4*)(P.a0 + c), kkw = *(const f32x4*)(P.k_k + c), kaw = *(const f32x4*)(P.k_a + c), rkw = *(const f32x4*)(P.r_k + c);
        const f32x4 r4 = unpack4(*(const u32x2*)(P.R + (size_t)tok * DM + c)), k4 = unpack4(*(const u32x2*)(P.K + (size_t)tok * DM + c));
        if (own) {
            f32x4 v4 = unpack4(*(const u32x2*)(P.V + (size_t)tok * DM + c));
            if (has_v) {
                const bf16x8 xv0 = *(const bf16x8*)(lh + 128);
                const f32x4 an = MFMA16(*(const bf16x8*)(P.L2V + (size_t)crow * 32 + 8 * fq), xv0, z4);
                const f32x4 vf4 = unpack4(*(const u32x2*)(P.VF + (size_t)tok * DM + c)), v0v = *(const f32x4*)(P.v0 + c);
#pragma unroll
                for (int j = 0; j < 4; ++j) v4[j] = v4[j] + (vf4[j] - v4[j]) * sigmoidf_(v0v[j] + an[j]);
                *(u32x2*)(P.V + (size_t)tok * DM + c) = pack4(v4);
            }
            *(LAS f32x4*)(p + 320 + 16 * cc) = v4;
        }
        f32x4 dec, kkv, bq, kp;
#pragma unroll
        for (int j = 0; j < 4; ++j) {
            dec[j] = __expf(-0.60653065971263342f * sigmoidf_(w0v[j] + aw[j]));
            const float as = sigmoidf_(a0v[j] + aa[j]);
            const float kk = k4[j] * kkw[j]; kkv[j] = kk; bq[j] = kk * as; ss += kk * kk;
            const float kq = k4[j] * (1.0f + (as - 1.0f) * kaw[j]); kp[j] = kq;
            rk += r4[j] * kq * rkw[j];
        }
        *(LAS f32x4*)(p + 16 * ct) = dec;
        kkq[cc] = kkv; bqq[cc] = bq;
        *(LAS f32x4*)(p + 192 + 16 * ct) = kp;
        *(LAS f32x4*)(p + 256 + 16 * ct) = r4;
    }
#pragma unroll
    for (int cc = 0; cc < 2; ++cc) { const int c2 = 64 * h + 16 * (2 * (1 - cp) + cc) + 4 * fq;
        const f32x4 ko = unpack4(*(const u32x2*)(P.K + (size_t)tok * DM + c2)) * *(const f32x4*)(P.k_k + c2);
        ss += (ko[0] * ko[0] + ko[1] * ko[1]) + (ko[2] * ko[2] + ko[3] * ko[3]); }
    ss += __shfl_xor(ss, 16); ss += __shfl_xor(ss, 32);
    rk += __shfl_xor(rk, 16); rk += __shfl_xor(rk, 32);
    const float inv = 1.0f / fmaxf(sqrtf(ss), 1e-12f);
#pragma unroll
    for (int cc = 0; cc < 2; ++cc) { const int ct = 2 * cp + cc;
        *(LAS f32x4*)(p + 64 + 16 * ct) = kkq[cc] * (-inv);
        *(LAS f32x4*)(p + 128 + 16 * ct) = bqq[cc] * inv; }
    if (fq == 0) { if (half == 0) P.RK[((size_t)((tok / TS) * 16 + h) * 2 + cp) * TS + (tok % TS)] = rk; }
}
typedef float f32x2 __attribute__((ext_vector_type(2)));
struct ScanOps { f32x4 w0, w1, a0, a1, b0, b1, k0, k1, r0, r1; float v; };
__device__ __forceinline__ void scan_load(ScanOps& o, const LAS float* p, const LAS float* pv, const LAS float* pn) {
    o.w0 = *(const LAS f32x4*)(p); o.w1 = *(const LAS f32x4*)(p + 4); o.a0 = *(const LAS f32x4*)(p + 64); o.a1 = *(const LAS f32x4*)(p + 68);
    o.b0 = *(const LAS f32x4*)(p + 128); o.b1 = *(const LAS f32x4*)(p + 132); o.k0 = *(const LAS f32x4*)(p + 192); o.k1 = *(const LAS f32x4*)(p + 196);
    o.r0 = *(const LAS f32x4*)(p + 256); o.r1 = *(const LAS f32x4*)(p + 260);
    o.v = *pv; (void)pn;
}
#define LO2(v) ((f32x2){(v)[0], (v)[1]})
#define HI2(v) ((f32x2){(v)[2], (v)[3]})
__device__ __forceinline__ float scan_step(f32x2 (&S)[4], const ScanOps& o) {
    f32x2 t = S[0] * LO2(o.a0); t = S[1] * HI2(o.a0) + t; t = S[2] * LO2(o.a1) + t; t = S[3] * HI2(o.a1) + t;
    const float sa = red8(t[0] + t[1]);
    const f32x2 sa2 = (f32x2){sa, sa}, v2 = (f32x2){o.v, o.v};
    S[0] = S[0] * LO2(o.w0) + (sa2 * LO2(o.b0) + v2 * LO2(o.k0));
    S[1] = S[1] * HI2(o.w0) + (sa2 * HI2(o.b0) + v2 * HI2(o.k0));
    S[2] = S[2] * LO2(o.w1) + (sa2 * LO2(o.b1) + v2 * LO2(o.k1));
    S[3] = S[3] * HI2(o.w1) + (sa2 * HI2(o.b1) + v2 * HI2(o.k1));
    f32x2 y = S[0] * LO2(o.r0); y = S[1] * HI2(o.r0) + y; y = S[2] * LO2(o.r1) + y; y = S[3] * HI2(o.r1) + y;
    return red8(y[0] + y[1]);
}
__device__ __forceinline__ void phase_scan(const ScanP& P, LAS unsigned char* lds, bool has_v) {
    int tid_ = threadIdx.x; asm volatile("" : "+v"(tid_)); const int tid = tid_, lane = tid & 63, wave = __builtin_amdgcn_readfirstlane(tid >> 6), fr = lane & 15, fq = lane >> 4;
    LAS float* ring = (LAS float*)lds; LAS float* ybuf = ring + 2 * SC_BUF;
    const int row = (tid >> 3) & 31, cgi = tid & 7, cg8 = cgi * 8;
    const int pw = (wave - 4) & 3, ptt = pw & 1, pcp = pw >> 1, psr = 16 * ptt + fr;
    for (int unit = (gridDim.x == 256) ? (int)((blockIdx.x & 7) * 32 + (blockIdx.x >> 3)) : (int)blockIdx.x; unit < 256; unit += gridDim.x) {
        const int pair = unit >> 1, half = unit & 1, b = pair >> 4, h = pair & 15, m0 = b * TS;
        if (wave >= 4) scan_produce(P, ring, m0 + psr, psr, h, half, pcp, fr, fq, has_v);
        __syncthreads();
        f32x2 S2[4];
#pragma unroll
        for (int j = 0; j < 4; ++j) S2[j] = (f32x2){0.f, 0.f};
        float yk = 0.f;
        for (int c = 0; c < TS / SC_TC; ++c) {
            LAS float* buf = ring + (c & 1) * SC_BUF;
            if (wave < 4) {
                LAS float* yb = ybuf + (c & 1) * 1024;
                const LAS float* pb = buf + cg8;
                const LAS float* pv = buf + 320 + row;
                const LAS float* pn = buf + 352;
                ScanOps A, B;
                scan_load(A, pb, pv, pn);
#pragma unroll 1
                for (int s = 0; s < SC_TC; s += 8) {
#pragma unroll
                    for (int u = 0; u < 8; u += 2) {
                        scan_load(B, pb + (s + u + 1) * SC_STEP, pv + (s + u + 1) * SC_STEP, pn + (s + u + 1) * SC_STEP);
                        { const float y = scan_step(S2, A); yk = (cgi == u) ? y : yk; }
                        scan_load(A, pb + ((s + u + 2) & (SC_TC - 1)) * SC_STEP, pv + ((s + u + 2) & (SC_TC - 1)) * SC_STEP, pn + ((s + u + 2) & (SC_TC - 1)) * SC_STEP);
                        { const float y = scan_step(S2, B); yk = (cgi == u + 1) ? y : yk; }
                    }
                    yb[(s + cgi) * 32 + row] = yk;
                }
            } else if (c + 1 < TS / SC_TC) {
                scan_produce(P, ring + ((c + 1) & 1) * SC_BUF, m0 + (c + 1) * SC_TC + psr, psr, h, half, pcp, fr, fq, has_v);
            }
            __syncthreads();
            if (wave < 4) {
                const int step = tid >> 3, r4 = (tid & 7) * 4;
                const f32x4 yv = *(const LAS f32x4*)(ybuf + (c & 1) * 1024 + step * 32 + r4);
                *(u32x2*)(P.Y + (size_t)(m0 + c * SC_TC + step) * DM + 64 * h + 32 * half + r4) = pack4(yv);
            }
        }
        __syncthreads();
    }
}
constexpr int PO_ROWB = 336, PO_TILE = 64 * PO_ROWB;
__device__ __forceinline__ void phase_post(LAS unsigned char* lds, bf16_t* Y, const bf16_t* V, const float* RK, const bf16_t* LH, const bf16_t* L2G, const float* lnx_g, const float* lnx_b) {
    int tid_ = threadIdx.x; asm volatile("" : "+v"(tid_)); const int tid = tid_, lane = tid & 63, wave = tid >> 6, fr = lane & 15, fq = lane >> 4;
    for (int blk = ((gridDim.x == 256) ? (int)((blockIdx.x & 7) * 32 + (blockIdx.x >> 3)) : (int)blockIdx.x); blk < MT / 128; blk += gridDim.x) {
        const int tok = blk * 128 + wave * 16 + fr;
        bf16x8 xg[5];
#pragma unroll
        for (int kk = 0; kk < 5; ++kk) xg[kk] = *(const bf16x8*)(LH + (size_t)tok * 320 + 160 + 32 * kk + 8 * fq);
        u32x4 wreg[3];
#pragma unroll
        for (int i = 0; i < 3; ++i) { const int q = tid + 512 * i; if (q < 1280) wreg[i] = *(const u32x4*)(L2G + (size_t)q * 8); }
#pragma unroll
        for (int i = 0; i < 3; ++i) { const int q = tid + 512 * i; if (q < 1280) *(LAS u32x4*)(lds + (q / 20) * PO_ROWB + (q % 20) * 16) = wreg[i]; }
        __syncthreads();
#pragma unroll 1
        for (int h = 0; h < 16; ++h) {
            if (h + 1 < 16) {
#pragma unroll
                for (int i = 0; i < 3; ++i) { const int q = tid + 512 * i; if (q < 1280) wreg[i] = *(const u32x4*)(L2G + (size_t)(h + 1) * 10240 + (size_t)q * 8); } }
            const size_t rki = ((size_t)((tok / TS) * 16 + h) * 2) * TS + (tok % TS); const float rk = RK[rki] + RK[rki + TS];
            const LAS unsigned char* wt = lds + (h & 1) * PO_TILE + fq * 16;
            f32x4 yv[4], g[4]; float s = 0.f;
#pragma unroll
            for (int p = 0; p < 2; ++p) {
                const int c8 = 64 * h + 32 * p + 8 * fq;
#pragma unroll
                for (int t = 0; t < 2; ++t) {
                    const int lrow = 32 * p + 8 * (fr >> 2) + 4 * t + (fr & 3);
                    f32x4 acc = (f32x4){0.f, 0.f, 0.f, 0.f};
#pragma unroll
                    for (int kk = 0; kk < 5; ++kk) acc = MFMA16(*(const LAS bf16x8*)(wt + lrow * PO_ROWB + 64 * kk), xg[kk], acc);
                    g[2 * p + t] = acc; }
                const u32x4 yr = *(const u32x4*)(Y + (size_t)tok * DM + c8);
                yv[2 * p] = unpack4((u32x2){yr.x, yr.y}); yv[2 * p + 1] = unpack4((u32x2){yr.z, yr.w});
                s += (yv[2 * p][0] + yv[2 * p][1]) + (yv[2 * p][2] + yv[2 * p][3]) + (yv[2 * p + 1][0] + yv[2 * p + 1][1]) + (yv[2 * p + 1][2] + yv[2 * p + 1][3]);
            }
            s += __shfl_xor(s, 16); s += __shfl_xor(s, 32);
            const float mean = s * (1.f / 64.f); float q = 0.f;
#pragma unroll
            for (int ct = 0; ct < 4; ++ct) { yv[ct] = yv[ct] - mean; q += (yv[ct][0] * yv[ct][0] + yv[ct][1] * yv[ct][1]) + (yv[ct][2] * yv[ct][2] + yv[ct][3] * yv[ct][3]); }
            q += __shfl_xor(q, 16); q += __shfl_xor(q, 32);
            const float rstd = __builtin_amdgcn_rsqf(q * (1.f / 64.f) + LNX_EPS);
#pragma unroll
            for (int p = 0; p < 2; ++p) {
                const int c8 = 64 * h + 32 * p + 8 * fq;
                const u32x4 vr = *(const u32x4*)(V + (size_t)tok * DM + c8);
                const f32x4 o0 = (yv[2 * p] * rstd * *(const f32x4*)(lnx_g + c8) + *(const f32x4*)(lnx_b + c8) + unpack4((u32x2){vr.x, vr.y}) * rk) * g[2 * p];
                const f32x4 o1 = (yv[2 * p + 1] * rstd * *(const f32x4*)(lnx_g + c8 + 4) + *(const f32x4*)(lnx_b + c8 + 4) + unpack4((u32x2){vr.z, vr.w}) * rk) * g[2 * p + 1];
                u32x4 o; o.x = pk2(o0[0], o0[1]); o.y = pk2(o0[2], o0[3]); o.z = pk2(o1[0], o1[1]); o.w = pk2(o1[2], o1[3]);
                *(u32x4*)(Y + (size_t)tok * DM + c8) = o;
            }
            if (h + 1 < 16) {
#pragma unroll
                for (int i = 0; i < 3; ++i) { const int q = tid + 512 * i; if (q < 1280) *(LAS u32x4*)(lds + ((h + 1) & 1) * PO_TILE + (q / 20) * PO_ROWB + (q % 20) * 16) = wreg[i]; } }
            __syncthreads();
        }
    }
}
constexpr int SG_WRS = 272, SG_WT = 128 * SG_WRS;
constexpr int SG_RS = 260, SG_VN = 128 * SG_RS;
__device__ __forceinline__ void sgu_stage(LAS unsigned char* vn, const LAS float* st, const u32x4 (&raw)[4], const float* ln_g, const float* ln_b, int g, int tid) {
#pragma unroll
    for (int q = 0; q < 4; ++q) { const int idx = tid + 512 * q, tok = idx >> 4, ch8 = (idx & 15) * 8;
        const float mean = st[2 * tok], rstd = st[2 * tok + 1];
        const f32x4 g0 = *(const f32x4*)(ln_g + 128 * g + ch8), g1 = *(const f32x4*)(ln_g + 128 * g + ch8 + 4), b0 = *(const f32x4*)(ln_b + 128 * g + ch8), b1 = *(const f32x4*)(ln_b + 128 * g + ch8 + 4);
        const f32x4 n0 = (unpack4((u32x2){raw[q].x, raw[q].y}) - mean) * rstd * g0 + b0, n1 = (unpack4((u32x2){raw[q].z, raw[q].w}) - mean) * rstd * g1 + b1;
        LAS unsigned* d = (LAS unsigned*)(vn + tok * SG_RS + ch8 * 2);
        d[0] = pk2(n0[0], n0[1]); d[1] = pk2(n0[2], n0[3]); d[2] = pk2(n1[0], n1[1]); d[3] = pk2(n1[2], n1[3]); }
}
__device__ __forceinline__ void phase_sgu(LAS unsigned char* lds, bf16_t* U, const bf16_t* VG, const float* ln_g, const float* ln_b, const bf16_t* WSM, const float* b_s) {
    int tid_ = threadIdx.x; asm volatile("" : "+v"(tid_)); const int tid = tid_, lane = tid & 63, wave = __builtin_amdgcn_readfirstlane(tid >> 6), fr = lane & 15, fq = lane >> 4;
    LAS float* st = (LAS float*)lds; LAS unsigned char* vn0 = lds + 1024; LAS unsigned char* ws0 = vn0 + 2 * SG_VN;
    for (int unit = ((gridDim.x == 256) ? (int)((blockIdx.x & 7) * 32 + (blockIdx.x >> 3)) : (int)blockIdx.x); unit < MT / 128; unit += gridDim.x) {
        const size_t m0 = (size_t)unit * 128;
#pragma unroll 1
        for (int tk = 0; tk < 16; tk += 4) {
            float s1[4], s2[4];
#pragma unroll
            for (int r = 0; r < 4; ++r) { const bf16_t* rowp = VG + (m0 + 16 * wave + tk + r) * EW + 8 * lane; s1[r] = 0.f; s2[r] = 0.f;
#pragma unroll
                for (int q = 0; q < 4; ++q) { const u32x4 raw = *(const u32x4*)(rowp + 512 * q); const f32x4 a = unpack4((u32x2){raw.x, raw.y}), b = unpack4((u32x2){raw.z, raw.w});
                    s1[r] += (a[0] + a[1]) + (a[2] + a[3]) + (b[0] + b[1]) + (b[2] + b[3]);
                    s2[r] += (a[0] * a[0] + a[1] * a[1]) + (a[2] * a[2] + a[3] * a[3]) + (b[0] * b[0] + b[1] * b[1]) + (b[2] * b[2] + b[3] * b[3]); } }
#pragma unroll
            for (int o = 1; o < 64; o <<= 1) {
#pragma unroll
                for (int r = 0; r < 4; ++r) { s1[r] += __shfl_xor(s1[r], o); s2[r] += __shfl_xor(s2[r], o); } }
            if (lane == 0) {
#pragma unroll
                for (int r = 0; r < 4; ++r) { const float m = s1[r] * (1.f / EW); const float var = fmaxf(s2[r] * (1.f / EW) - m * m, 0.f);
                    st[2 * (16 * wave + tk + r)] = m; st[2 * (16 * wave + tk + r) + 1] = __builtin_amdgcn_rsqf(var + LN_EPS); } }
        }
        u32x4 raw[4];
#pragma unroll
        for (int q = 0; q < 4; ++q) { const int idx = tid + 512 * q; raw[q] = *(const u32x4*)(VG + (m0 + (idx >> 4)) * EW + (idx & 15) * 8); }
        u32x4 wsr[4];
#pragma unroll
        for (int q = 0; q < 4; ++q) { const int idx = tid + 512 * q; wsr[q] = *(const u32x4*)(WSM + (size_t)idx * 8); }
        __syncthreads();
        sgu_stage(vn0, st, raw, ln_g, ln_b, 0, tid);
#pragma unroll
        for (int q = 0; q < 4; ++q) { const int idx = tid + 512 * q; *(LAS u32x4*)(ws0 + (idx >> 4) * SG_WRS + (idx & 15) * 16) = wsr[q]; }
        __syncthreads();
#pragma unroll 1
        for (int g = 0; g < 16; ++g) {
            const LAS unsigned char* vn = vn0 + (g & 1) * SG_VN;
            if (g + 1 < 16) {
#pragma unroll
                for (int q = 0; q < 4; ++q) { const int idx = tid + 512 * q; raw[q] = *(const u32x4*)(VG + (m0 + (idx >> 4)) * EW + 128 * (g + 1) + (idx & 15) * 8); wsr[q] = *(const u32x4*)(WSM + (size_t)(g + 1) * 16384 + (size_t)idx * 8); } }
            const LAS unsigned char* wsl = ws0 + (g & 1) * SG_WT + fr * SG_WRS + fq * 16;
            const int cw = wave & 3, th = wave >> 2, c8 = 128 * g + 32 * cw + 8 * fq;
            u32x4 uraw[4]; float bias[4];
#pragma unroll
            for (int q = 0; q < 4; ++q) { const int tokl = 16 * (th + 2 * q) + fr; uraw[q] = *(const u32x4*)(U + (m0 + tokl) * EW + c8); bias[q] = b_s[g * 128 + tokl]; }
            bf16x8 af[2][4];
#pragma unroll
            for (int t = 0; t < 2; ++t)
#pragma unroll
                for (int s = 0; s < 4; ++s)
#pragma unroll
                    for (int e = 0; e < 8; ++e) af[t][s][e] = *(const LAS short*)(vn + (32 * s + 8 * fq + e) * SG_RS + (32 * cw + 8 * (fr >> 2) + 4 * t + (fr & 3)) * 2);
#pragma unroll
            for (int q = 0; q < 4; ++q) {
                const int tokl = 16 * (th + 2 * q) + fr;
                f32x4 acc0 = (f32x4){0.f, 0.f, 0.f, 0.f}, acc1 = acc0;
#pragma unroll
                for (int s = 0; s <= q; ++s) { const bf16x8 wf = *(const LAS bf16x8*)(wsl + 16 * (th + 2 * q) * SG_WRS + 64 * s);
                    acc0 = MFMA16(af[0][s], wf, acc0); acc1 = MFMA16(af[1][s], wf, acc1); }
                const f32x4 u0 = unpack4((u32x2){uraw[q].x, uraw[q].y}) * (acc0 + bias[q]), u1 = unpack4((u32x2){uraw[q].z, uraw[q].w}) * (acc1 + bias[q]);
                u32x4 o; o.x = pk2(u0[0], u0[1]); o.y = pk2(u0[2], u0[3]); o.z = pk2(u1[0], u1[1]); o.w = pk2(u1[2], u1[3]);
                *(u32x4*)(U + (m0 + tokl) * EW + c8) = o;
            }
            if (g + 1 < 16) sgu_stage(vn0 + ((g + 1) & 1) * SG_VN, st, raw, ln_g, ln_b, g + 1, tid);
            if (g + 1 < 16) {
#pragma unroll
                for (int q = 0; q < 4; ++q) { const int idx = tid + 512 * q; *(LAS u32x4*)(ws0 + ((g + 1) & 1) * SG_WT + (idx >> 4) * SG_WRS + (idx & 15) * 16) = wsr[q]; } }
            __syncthreads();
        }
    }
}
#define RLX_AGENT __ATOMIC_RELAXED, __HIP_MEMORY_SCOPE_AGENT
#define XB_TMO      128
#define XB_XCNT(j)  (256  + 64 * (j))
#define XB_XSUB(j)  (1280 + 64 * (j))
#define XB_XGEN(j)  (2304 + 64 * (j))
#define XB_TOP      3328
#define XB_TOPGEN   3392
#define XCD_BAR_WORDS 3456
#define XB_SPIN_CAP (1u << 18)

__device__ __forceinline__ unsigned xb_ld(unsigned* p)              { return __hip_atomic_load(p, __ATOMIC_RELAXED, __HIP_MEMORY_SCOPE_AGENT); }
__device__ __forceinline__ unsigned xb_add(unsigned* p, unsigned v) { return __hip_atomic_fetch_add(p, v, __ATOMIC_RELAXED, __HIP_MEMORY_SCOPE_AGENT); }
__device__ __forceinline__ unsigned xb_xcc_id() { return (unsigned)__builtin_amdgcn_s_getreg((3 << 11) | 20) & 0xFu; }
#define XB_SPIN(cond, bar) do { unsigned _sp = 0; while (cond) { __builtin_amdgcn_s_sleep(1); \
    if ((++_sp & 255u) == 0u) { if (xb_ld(&(bar)[XB_TMO])) break; if (_sp > XB_SPIN_CAP) { atomicAdd(&(bar)[XB_TMO], 1u); break; } } } } while (0)

struct XcdBarrier {
    unsigned* bar; unsigned x;
    volatile LAS unsigned* st;
};

__device__ __forceinline__ XcdBarrier xcd_barrier_post(unsigned* bar, volatile LAS unsigned* st) {
    XcdBarrier b; b.bar = bar; b.x = xb_xcc_id(); b.st = st;
    if (threadIdx.x == 0) (void)xb_add(&bar[XB_XCNT(b.x)], 1u);
    return b;
}
__device__ __forceinline__ void xcd_barrier_complete(unsigned* bar, unsigned x, unsigned& nloc, unsigned& nx) {
    const unsigned G = gridDim.x * gridDim.y * gridDim.z;
    unsigned sum, cnt, mine, sp = 0u;
    for (;;) {
        sum = 0u; cnt = 0u; mine = 0u;
#pragma unroll
        for (unsigned j = 0; j < 16; ++j) { const unsigned c = xb_ld(&bar[XB_XCNT(j)]); sum += c; cnt += (c > 0u) ? 1u : 0u; mine = (j == x) ? c : mine; }
        if (sum == G) break;
        __builtin_amdgcn_s_sleep(1);
        if ((++sp & 255u) == 0u) { if (xb_ld(&bar[XB_TMO])) break; if (sp > XB_SPIN_CAP) { atomicAdd(&bar[XB_TMO], 1u); break; } }
    }
    nloc = mine > 0u ? mine : 1u; nx = cnt > 0u ? cnt : 1u;
}

__device__ __forceinline__ void xcd_barrier(const XcdBarrier& b) {
    asm volatile("s_waitcnt vmcnt(0)" ::: "memory");
    __syncthreads();
    if (threadIdx.x == 0) {
        unsigned* bar = b.bar;
        __builtin_amdgcn_s_waitcnt(0);
        unsigned nloc = b.st[0], nx = b.st[1];
        if (nloc == 0u) { xcd_barrier_complete(bar, b.x, nloc, nx); b.st[0] = nloc; b.st[1] = nx; }
        const unsigned old = xb_add(&bar[XB_XSUB(b.x)], 1u);
        const unsigned gen = old / nloc;
        if (old + 1u == (gen + 1u) * nloc) {
            __builtin_amdgcn_fence(__ATOMIC_RELEASE, "agent");
            asm volatile("s_waitcnt vmcnt(0)" ::: "memory");
            const unsigned og = xb_add(&bar[XB_TOP], 1u);
            const unsigned tg = og / nx;
            if (og + 1u == (tg + 1u) * nx) xb_add(&bar[XB_TOPGEN], 1u);
            else XB_SPIN(xb_ld(&bar[XB_TOPGEN]) == tg, bar);
            __builtin_amdgcn_fence(__ATOMIC_ACQUIRE, "agent");
            xb_add(&bar[XB_XGEN(b.x)], 1u);
            asm volatile("s_waitcnt vmcnt(0)" ::: "memory");
        } else {
            XB_SPIN(xb_ld(&bar[XB_XGEN(b.x)]) == gen, bar);
            __builtin_amdgcn_fence(__ATOMIC_ACQUIRE, "agent");
            asm volatile("s_waitcnt vmcnt(0)" ::: "memory");
        }
    }
    __syncthreads();
}

struct Args { const float* in[31]; float* out; unsigned char* ws; int ph; int pad; };
constexpr int N_PHASES = 35;
#ifndef N_RUN
#define N_RUN 35
#endif
#ifndef PH_MASK
#define PH_MASK 0xffff
#endif
#define PHM(b) ((PH_MASK >> (b)) & 1)


#ifndef MK_MULTI
#define MK_MULTI 0
#endif

template <class Epi>
__device__ __forceinline__ void run_gemm(LAS unsigned char* lds, const bf16_t* A, const bf16_t* Bt, int N, int K, const Epi& E) {
    pg8::Gemm g{A, Bt, MT, N, K}; pg8::StaticOrder S; S.init(MT, N, (int)gridDim.x, (int)blockIdx.x); if (N <= 1024 && K > 1024) S.wgm_ = pg8::WGM;
    pg8::gemm_phase<Epi, pg8::StaticOrder, true, true>(lds, g, S, E);
}

__global__ void __launch_bounds__(NTHREADS) fwd_megakernel(Args args) {
    extern __shared__ __attribute__((aligned(16))) unsigned char lds_raw[];
    LAS unsigned char* lds = (LAS unsigned char*)lds_raw;
    cg::grid_group grid = cg::this_grid();
    const bool all = args.ph < 0; int cur = 0;
#define RUN (all || (cur++ == args.ph))
#define SEAM() do { if (all) xcd_barrier(xbar); } while (0)
    In in;
#pragma unroll
    for (int i = 0; i < 31; ++i) in.p[i] = args.in[i];
    unsigned char* ws = args.ws;
    bf16_t* Wb = (bf16_t*)(ws + WS_W);
    bf16_t* VF = (bf16_t*)(ws + WS_VF); bf16_t* XB = (bf16_t*)(ws + WS_XB);
    unsigned char* big = ws + WS_BIG;
    float* RK = (float*)(ws + WS_RK);
    float* XF = args.out; float* ST = (float*)(ws + WS_ST);

    unsigned* barw = (unsigned*)(ws + WS_CTL);
    volatile LAS unsigned* bst = (volatile LAS unsigned*)(lds + LDS_BYTES - 64);
    if (threadIdx.x < 2) bst[threadIdx.x] = 0u;
    if (all && blockIdx.x == 0) for (int u = threadIdx.x; u < XCD_BAR_WORDS; u += NTHREADS) barw[u] = 0u;
    if (PHM(0) && RUN) phase_convert(in, Wb, lds);
    XcdBarrier xbar; xbar.bar = barw; xbar.x = 0; xbar.st = bst;
    if (all) { grid.sync(); xbar = xcd_barrier_post(barw, bst); }
    for (int i = 0; i < 4; ++i) {
        const int j = i >> 1;
        const float* xin = (i == 0) ? in.p[0] : XF;
        const bf16_t* WF = Wb + WF_OFF + (size_t)i * WF_SZ;
        const bf16_t* mixA; const bf16_t* mixB; int mixK; const float* mixSt = nullptr;
        if ((i & 1) == 0) {
            const bool has_v = j > 0;
            const bf16_t* WA = Wb + (size_t)j * WA_SZ;
            const float* mu = in.p[1] + (size_t)j * 6 * DM;
            bf16_t* Rb = (bf16_t*)(big + BIG_R); bf16_t* Kb = (bf16_t*)(big + BIG_K); bf16_t* Vb = has_v ? (bf16_t*)(big + BIG_V) : VF; bf16_t* LH = (bf16_t*)(big + BIG_LH);
            bf16_t* XK2 = (bf16_t*)(big + BIG_V);
            bf16_t* XV2 = has_v ? nullptr : (bf16_t*)XF;
            if (PHM(1) && RUN) phase_prep0(lds, xin, mu, WA + WA_L1T, XB, XK2, XV2, LH, has_v);
            SEAM();
            if (PHM(3) && RUN) {
                const int nc = XV2 ? 3 : 2;
                for (int c = 0; c < nc; ++c) { pg8::EpiBf16<0> E{c == 0 ? Rb : (c == 1 ? Kb : Vb), DM, nullptr, 0, 0}; run_gemm(lds, c == 0 ? XB : (c == 1 ? XK2 : XV2), WA + WA_RKV + (size_t)c * M1, DM, DM, E); } }
            SEAM();
            if (!XV2) {
                if (PHM(2) && RUN) phase_shift(xin, mu + 3 * DM, XB);
                SEAM();
                if (PHM(3) && RUN) { pg8::EpiBf16<0> E{Vb, DM, nullptr, 0, 0}; run_gemm(lds, XB, WA + WA_RKV + (size_t)2 * M1, DM, DM, E); }
                SEAM();
            }
            if (PHM(4) && RUN) { ScanP P{Rb, Kb, Vb, VF, LH, WA + WA_L2W, WA + WA_L2A, WA + WA_L2V, in.p[3] + j * DM, in.p[6] + j * DM, in.p[9] + (has_v ? (j - 1) * DM : 0), in.p[14] + j * DM, in.p[15] + j * DM, in.p[16] + j * DM, XB, RK};
                phase_scan(P, lds, has_v);
            }
            SEAM();
                        if (PHM(5) && RUN) phase_post(lds, XB, Vb, RK, LH, WA + WA_L2G, in.p[17] + j * DM, in.p[18] + j * DM);
            SEAM();
            mixA = XB; mixB = WA + WA_OUT; mixK = DM;
        } else {
            const bf16_t* WB = Wb + WB_OFF + (size_t)j * WB_SZ;
            bf16_t* U = (bf16_t*)(big + BIG_U); bf16_t* VG = (bf16_t*)(big + BIG_VG);
            if (PHM(6) && RUN) { pg8::EpiBf16<1> E{U, EW, in.p[21] + (size_t)j * 2 * EW, EW, (size_t)MT * EW}; run_gemm(lds, XB, WB + WB_IN, 2 * EW, DM, E); }
            SEAM();
                        if (PHM(7) && RUN) phase_sgu(lds, U, VG, in.p[22] + j * EW, in.p[23] + j * EW, WB + WB_WS, in.p[25] + j * 2048);
            SEAM();
            mixA = U; mixB = WB + WB_OUT; mixK = EW; mixSt = ST;
        }
        if (PHM(8) && RUN) { pg8::EpiResid E{xin, mixSt, in.p[29] + (size_t)(2 * i - 1) * DM, in.p[30] + (size_t)(2 * i - 1) * DM, XF, DM, ALPHA}; run_gemm(lds, mixA, mixB, DM, mixK, E); }
        SEAM();
        if (PHM(9) && RUN) phase_ln(XF, in.p[29] + (size_t)(2 * i) * DM, in.p[30] + (size_t)(2 * i) * DM, nullptr, XB, ST);
        SEAM();
        bf16_t* H = (bf16_t*)(big + BIG_H);
        if (PHM(10) && RUN) { pg8::EpiSwiglu E{H, FF}; run_gemm(lds, XB, WF + WF_GU, 2 * FF, DM, E);
        }
        SEAM();
        if (PHM(11) && RUN) { pg8::EpiResid E{XF, ST, in.p[29] + (size_t)(2 * i) * DM, in.p[30] + (size_t)(2 * i) * DM, XF, DM, ALPHA};
            run_gemm(lds, H, WF + WF_DN, DM, FF, E); }
        SEAM();
        if (PHM(12) && RUN) phase_ln(XF, in.p[29] + (size_t)(2 * i + 1) * DM, in.p[30] + (size_t)(2 * i + 1) * DM, (i & 1) ? XF : nullptr, (i & 1) ? nullptr : XB, ST);
        if (i < 3) SEAM();
    }
#undef RUN
#undef SEAM
}

extern "C" void kernel_launch(void* const* d_in, const int* in_sizes, int n_in, void* d_out, int out_size, void* d_ws, size_t ws_size, hipStream_t stream) {
    static int grid = 0;
    if (grid == 0) {
        if (n_in != 31 || out_size != MT * DM || ws_size < WS_END) { fprintf(stderr, "kernel_launch: unexpected shapes: n_in %d out %d ws %zu\n", n_in, out_size, ws_size); grid = -1; return; }
        int dev = 0, cus = 0, per_cu = 0;
        hipGetDevice(&dev); hipDeviceGetAttribute(&cus, hipDeviceAttributeMultiprocessorCount, dev);
        if (hipFuncSetAttribute((const void*)fwd_megakernel, hipFuncAttributeMaxDynamicSharedMemorySize, LDS_BYTES) != hipSuccess) { fprintf(stderr, "kernel_launch: hipFuncSetAttribute failed\n"); grid = -1; return; }
        if (hipOccupancyMaxActiveBlocksPerMultiprocessor(&per_cu, (const void*)fwd_megakernel, NTHREADS, LDS_BYTES) != hipSuccess || per_cu < 1) { fprintf(stderr, "kernel_launch: occupancy query gave %d\n", per_cu); per_cu = 1; }
        (void)hipGetLastError();
        grid = cus * per_cu;
        fprintf(stderr, "kernel_launch: grid %d (cus %d x %d)\n", grid, cus, per_cu);
    }
    if (grid < 0) return;
    Args a{};
    for (int i = 0; i < 31; ++i) a.in[i] = (const float*)d_in[i];
    a.out = (float*)d_out; a.ws = (unsigned char*)d_ws; a.pad = 0;
#if MK_MULTI
    for (int ph = 0; ph < N_RUN; ++ph) { a.ph = ph; hipLaunchKernelGGL(fwd_megakernel, dim3(grid), dim3(NTHREADS), LDS_BYTES, stream, a); }
#else
    a.ph = -1;
    void* kargs[] = {&a};
    hipError_t e = hipLaunchCooperativeKernel((const void*)fwd_megakernel, dim3(grid), dim3(NTHREADS), kargs, LDS_BYTES, stream);
    if (e != hipSuccess) fprintf(stderr, "cooperative launch failed: %s (grid %d)\n", hipGetErrorString(e), grid);
#endif
}
```

```cpp
#include <hip/hip_runtime.h>
#include <hip/hip_cooperative_groups.h>
#include <cstdio>
namespace cg = cooperative_groups;

namespace pg8 {
#define PG8_LAS __attribute__((address_space(3)))
typedef unsigned short bf16_t;
typedef short bf16x8 __attribute__((ext_vector_type(8)));
typedef float f32x4 __attribute__((ext_vector_type(4)));
typedef unsigned u32x4 __attribute__((ext_vector_type(4)));
constexpr int BM = 256, BK = 64, HALF = 128, HTB = HALF * BK * 2  , STAGE_BYTES = 8 * HTB, NXCD = 8, WGM = 4;

__host__ __device__ __forceinline__ int lds_byte(int r, int c) { const int st = (r >> 4) * 2 + (c >> 5), rr = r & 15, cc = c & 31, ob = rr * 64 + cc * 2; return st * 1024 + (ob ^ (((ob >> 9) & 1) << 5)); }
__host__ __device__ __forceinline__ void stage_rc(int b, int& R, int& C) { const int st = b / 1024, sb = b % 1024, swz = sb ^ (((sb >> 9) & 1) << 5); R = (st >> 1) * 16 + swz / 64; C = (st & 1) * 32 + (swz % 64) / 2; }
__host__ __device__ __forceinline__ int perm32(int rho) { const int n = rho >> 4, i = rho & 15; return 8 * (i >> 2) + 4 * n + (i & 3); }

struct Unit { int pm, pn; };
struct Gemm { const bf16_t* A; const bf16_t* Bt; int M, N, K; };

struct StaticOrder {
    int nM, nN, nwg, G, c;
    __host__ __device__ void init(int M, int N, int G_, int c_) { nM = M / BM; nN = N / BM; nwg = nM * nN; G = G_; c = c_; }
    __host__ __device__ bool next(int i, Unit& u) const {
        const long L = (long)i * G + c; if (L >= nwg) return false;
        int wgid = (int)L; { const int q = nwg / NXCD, r = nwg % NXCD, xcd = wgid % NXCD, off = wgid / NXCD; wgid = (xcd < r ? xcd * (q + 1) : r * (q + 1) + (xcd - r) * q) + off; }
        const int wgm = (nN <= 4) ? 8 : WGM;
        const int nig = wgm * nN, gid = wgid / nig, fm = gid * wgm, gsz = (nM - fm) < wgm ? (nM - fm) : wgm;
        u.pm = fm + ((wgid % nig) % gsz); u.pn = (wgid % nig) / gsz; return true;
    }
    __device__ __forceinline__ void a_ready(const Unit&) const {}
    __device__ __forceinline__ void done(const Unit&) const {}
};

template <class Epi, class Sched, bool ALIGN_EPI = false, bool SP2 = false>
__device__ __forceinline__ void gemm_phase(PG8_LAS unsigned char* lds, const Gemm g, const Sched& S, const Epi& E) {
    int tid_ = threadIdx.x; asm volatile("" : "+v"(tid_)); const int tid = tid_, wid = __builtin_amdgcn_readfirstlane(tid >> 6), lane = tid & 63, wr = wid >> 2, wc = wid & 3, fr = lane & 15, fq = lane >> 4;
    const int K = g.K, nt = K / BK;
    unsigned voffA[2], voffB[2];
#pragma unroll
    for (int i = 0; i < 2; ++i) { int R, C; stage_rc(tid * 16 + i * 8192, R, C); const int Rb = Epi::PERM ? ((R & ~31) + perm32(R & 31)) : R;
        voffA[i] = (unsigned)(R * K + C) * 2u; voffB[i] = (unsigned)(Rb * K + C) * 2u; }
    const size_t kstep = (size_t)(BK * 2);
    const size_t hstep = (size_t)HALF * K * 2;
    const size_t tstep = 2 * hstep;
    const unsigned ldsw = (unsigned)wid * 1024u;
    const int aoff = lds_byte(wr * 64 + fr, fq * 8), boff = lds_byte(wc * 32 + fr, fq * 8);
#define PG8_SA(b, h) (((b) * 2 + (h)) * HTB)
#define PG8_SB(b, h) ((4 + (b) * 2 + (h)) * HTB)
#define PG8_STAGE(bufoff, gbase, voff) do { _Pragma("unroll") for (int _i = 0; _i < 2; ++_i) \
        __builtin_amdgcn_global_load_lds((const unsigned*)((const char*)(gbase) + (voff)[_i]), (PG8_LAS unsigned*)(lds + (bufoff) + ldsw + _i * 8192), 16, 0, 0); } while (0)
#define PG8_LDA(dst, b, h) do { _Pragma("unroll") for (int m = 0; m < 4; ++m) _Pragma("unroll") for (int k = 0; k < 2; ++k) dst[m][k] = *(const PG8_LAS bf16x8*)(lds + PG8_SA(b, h) + aoff + m * 2048 + k * 1024); } while (0)
#define PG8_LDB(dst, b, h) do { _Pragma("unroll") for (int n = 0; n < 2; ++n) _Pragma("unroll") for (int k = 0; k < 2; ++k) dst[n][k] = *(const PG8_LAS bf16x8*)(lds + PG8_SB(b, h) + boff + n * 2048 + k * 1024); } while (0)
#define PG8_MMA(ai, bj, At, Bt) do { __builtin_amdgcn_s_setprio(1); _Pragma("unroll") for (int m = 0; m < 4; ++m) _Pragma("unroll") for (int n = 0; n < 2; ++n) _Pragma("unroll") for (int k = 0; k < 2; ++k) \
        acc[ai][bj][m][n] = __builtin_amdgcn_mfma_f32_16x16x32_bf16(Bt[n][k], At[m][k], acc[ai][bj][m][n], 0, 0, 0); __builtin_amdgcn_s_setprio(0); } while (0)
#define PG8_WAIT_V(n) asm volatile("s_waitcnt vmcnt(" #n ")" ::: "memory")
#define PG8_WAIT_L(n) asm volatile("s_waitcnt lgkmcnt(" #n ")" ::: "memory")
#define PG8_BAR __builtin_amdgcn_s_barrier()
#define PG8_SCHED __builtin_amdgcn_sched_barrier(0)
    Unit cur, nxt; int ui = 0;
    if (!S.next(0, cur)) return;
    f32x4 acc[2][2][4][2];
#pragma unroll
    for (int a = 0; a < 2; ++a)
#pragma unroll
        for (int b = 0; b < 2; ++b)
#pragma unroll
            for (int m = 0; m < 4; ++m)
#pragma unroll
                for (int n = 0; n < 2; ++n) acc[a][b][m][n] = (f32x4){0.f, 0.f, 0.f, 0.f};
    bf16x8 At[4][2], B0[2][2], B1[2][2];
    const char* cA = (const char*)g.A + (size_t)cur.pm * tstep; const char* cB = (const char*)g.Bt + (size_t)cur.pn * tstep;
    S.a_ready(cur);
    if constexpr (SP2) {
        PG8_STAGE(PG8_SB(0, 0), cB, voffB); PG8_STAGE(PG8_SB(0, 1), cB + hstep, voffB); PG8_STAGE(PG8_SA(0, 0), cA, voffA); PG8_STAGE(PG8_SA(0, 1), cA + hstep, voffA);
        if (wr == 1) PG8_BAR;
        PG8_WAIT_V(2); PG8_BAR;
        PG8_STAGE(PG8_SB(1, 0), cB + kstep, voffB); PG8_STAGE(PG8_SA(1, 0), cA + kstep, voffA); PG8_STAGE(PG8_SB(1, 1), cB + hstep + kstep, voffB);
        PG8_WAIT_V(6); PG8_BAR;
    } else {
        PG8_STAGE(PG8_SB(0, 0), cB, voffB); PG8_STAGE(PG8_SA(0, 0), cA, voffA); PG8_STAGE(PG8_SB(0, 1), cB + hstep, voffB); PG8_STAGE(PG8_SA(0, 1), cA + hstep, voffA);
        if (wr == 1) PG8_BAR;
        PG8_WAIT_V(4); PG8_BAR;
        PG8_STAGE(PG8_SB(1, 0), cB + kstep, voffB); PG8_STAGE(PG8_SA(1, 0), cA + kstep, voffA); PG8_STAGE(PG8_SB(1, 1), cB + hstep + kstep, voffB);
        PG8_WAIT_V(6); PG8_BAR;
    }
    for (;;) {
        const bool has_next = S.next(ui + 1, nxt);
        const char* nA = has_next ? (const char*)g.A + (size_t)nxt.pm * tstep : cA; const char* nB = has_next ? (const char*)g.Bt + (size_t)nxt.pn * tstep : cB;
        for (int t = 0; t < nt; t += 2) {
            const bool last = (t == nt - 2);
            const char* a1 = cA + (size_t)(t + 1) * kstep;
            const char* a2 = last ? nA : cA + (size_t)(t + 2) * kstep; const char* b2 = last ? nB : cB + (size_t)(t + 2) * kstep;
            const char* a3 = a2 + kstep; const char* b3 = b2 + kstep;
            if (last && has_next) S.a_ready(nxt);
            if constexpr (SP2) {
            PG8_LDB(B0, 0, 0); PG8_LDB(B1, 0, 1); PG8_SCHED; PG8_LDA(At, 0, 0); PG8_STAGE(PG8_SA(1, 1), a1 + hstep, voffA);
            PG8_WAIT_V(8); PG8_WAIT_L(0); PG8_BAR; PG8_MMA(0, 0, At, B0); PG8_MMA(0, 1, At, B1); PG8_BAR; PG8_SCHED;
            PG8_LDA(At, 0, 1); PG8_STAGE(PG8_SB(0, 0), b2, voffB); PG8_STAGE(PG8_SB(0, 1), b2 + hstep, voffB); PG8_STAGE(PG8_SA(0, 0), a2, voffA);
            PG8_WAIT_V(8); PG8_WAIT_L(0); PG8_BAR; PG8_MMA(1, 0, At, B0); PG8_MMA(1, 1, At, B1); PG8_BAR; PG8_SCHED;
            PG8_LDB(B0, 1, 0); PG8_LDB(B1, 1, 1); PG8_SCHED; PG8_LDA(At, 1, 0); PG8_STAGE(PG8_SA(0, 1), a2 + hstep, voffA);
            PG8_WAIT_V(8); PG8_WAIT_L(0); PG8_BAR; PG8_MMA(0, 0, At, B0); PG8_MMA(0, 1, At, B1); PG8_BAR; PG8_SCHED;
            PG8_LDA(At, 1, 1); PG8_STAGE(PG8_SB(1, 0), b3, voffB); PG8_STAGE(PG8_SB(1, 1), b3 + hstep, voffB); PG8_STAGE(PG8_SA(1, 0), a3, voffA);
            PG8_WAIT_V(8); PG8_WAIT_L(0); PG8_BAR; PG8_MMA(1, 0, At, B0); PG8_MMA(1, 1, At, B1); PG8_BAR; PG8_SCHED;
            } else {
            PG8_LDB(B0, 0, 0); PG8_SCHED; PG8_LDA(At, 0, 0); PG8_STAGE(PG8_SA(1, 1), a1 + hstep, voffA);
            PG8_WAIT_L(8); PG8_BAR; PG8_WAIT_L(0); PG8_MMA(0, 0, At, B0); PG8_BAR; PG8_SCHED;
            PG8_LDB(B1, 0, 1); PG8_STAGE(PG8_SB(0, 0), b2, voffB);
            PG8_BAR; PG8_WAIT_L(0); PG8_MMA(0, 1, At, B1); PG8_BAR;
            PG8_LDA(At, 0, 1); PG8_STAGE(PG8_SA(0, 0), a2, voffA);
            PG8_BAR; PG8_WAIT_L(0); PG8_MMA(1, 0, At, B0); PG8_BAR; PG8_SCHED;
            PG8_STAGE(PG8_SB(0, 1), b2 + hstep, voffB);
            PG8_WAIT_V(6); PG8_BAR; PG8_MMA(1, 1, At, B1); PG8_BAR;
            PG8_LDB(B0, 1, 0); PG8_SCHED; PG8_LDA(At, 1, 0); PG8_STAGE(PG8_SA(0, 1), a2 + hstep, voffA);
            PG8_WAIT_L(8); PG8_BAR; PG8_WAIT_L(0); PG8_MMA(0, 0, At, B0); PG8_BAR; PG8_SCHED;
            PG8_LDB(B1, 1, 1); PG8_STAGE(PG8_SB(1, 0), b3, voffB);
            PG8_BAR; PG8_WAIT_L(0); PG8_MMA(0, 1, At, B1); PG8_BAR;
            PG8_LDA(At, 1, 1); PG8_STAGE(PG8_SA(1, 0), a3, voffA);
            PG8_BAR; PG8_WAIT_L(0); PG8_MMA(1, 0, At, B0); PG8_BAR; PG8_SCHED;
            PG8_STAGE(PG8_SB(1, 1), b3 + hstep, voffB);
            PG8_WAIT_V(6); PG8_BAR; PG8_MMA(1, 1, At, B1); PG8_BAR;
            }
        }
        if constexpr (ALIGN_EPI) { if (wr == 0) PG8_BAR; }
        if constexpr (!Epi::AFTER_DRAIN) { E(acc, cur, wr, wc, fr, fq); S.done(cur); }
        if (!has_next) break;
#pragma unroll
        for (int a = 0; a < 2; ++a)
#pragma unroll
            for (int b = 0; b < 2; ++b)
#pragma unroll
                for (int m = 0; m < 4; ++m)
#pragma unroll
                    for (int n = 0; n < 2; ++n) acc[a][b][m][n] = (f32x4){0.f, 0.f, 0.f, 0.f};
        cur = nxt; cA = nA; cB = nB; ++ui;
        if constexpr (ALIGN_EPI) { if (wr == 1) PG8_BAR; }
    }
    PG8_WAIT_V(0);
    if constexpr (!ALIGN_EPI) { if (wr == 0) PG8_BAR; }
    PG8_BAR;
    if constexpr (Epi::AFTER_DRAIN) { E.fused(acc, cur, wr, wc, fr, fq, lds, wid, lane); S.done(cur); }
#undef PG8_SA
#undef PG8_SB
#undef PG8_STAGE
#undef PG8_LDA
#undef PG8_LDB
#undef PG8_MMA
#undef PG8_WAIT_V
#undef PG8_WAIT_L
#undef PG8_BAR
#undef PG8_SCHED
}
typedef float f32x2_t __attribute__((ext_vector_type(2)));
typedef __bf16 bf16x2_t __attribute__((ext_vector_type(2)));
__device__ __forceinline__ unsigned cvt_pk_bf16(float lo, float hi) { f32x2_t v = {lo, hi}; bf16x2_t b = __builtin_convertvector(v, bf16x2_t); return __builtin_bit_cast(unsigned, b); }
__device__ __forceinline__ float fast_rcp(float x) { return __builtin_amdgcn_rcpf(x); }
__device__ __forceinline__ float sigmoidf_(float x) { return fast_rcp(1.0f + __expf(-x)); }
__device__ __forceinline__ float gelu_tanh(float x) { const float t = x * __builtin_fmaf(x * x, -0.10294324f, -2.3022082f);
    return x * fast_rcp(1.0f + __builtin_amdgcn_exp2f(t)); }

template <int ACT  > struct EpiBf16 {
    static constexpr bool PERM = true, AFTER_DRAIN = false;
    bf16_t* O; int ldc; const float* bias; int split_cols; size_t split_stride;
    __device__ __forceinline__ void operator()(const f32x4 (&acc)[2][2][4][2], const Unit& u, int wr, int wc, int fr, int fq) const {
        const int row0 = u.pm * BM + wr * 64 + fr; int colt = u.pn * BM; bf16_t* base = O;
        if (split_cols) { const int t = colt / split_cols; base += (size_t)t * split_stride; colt -= t * split_cols; }
        const int col0 = colt + wc * 32 + 8 * fq, bcol0 = u.pn * BM + wc * 32 + 8 * fq;
        f32x4 bv[2][2];
#pragma unroll
        for (int bj = 0; bj < 2; ++bj)
#pragma unroll
            for (int n = 0; n < 2; ++n) bv[bj][n] = (ACT == 1) ? *(const f32x4*)(bias + bcol0 + bj * HALF + 4 * n) : (f32x4){0.f, 0.f, 0.f, 0.f};
#pragma unroll
        for (int ai = 0; ai < 2; ++ai)
#pragma unroll
            for (int m = 0; m < 4; ++m) { bf16_t* rowp = base + (size_t)(row0 + ai * HALF + m * 16) * ldc + col0;
#pragma unroll
                for (int bj = 0; bj < 2; ++bj) { f32x4 v0 = acc[ai][bj][m][0] + bv[bj][0], v1 = acc[ai][bj][m][1] + bv[bj][1];
                    if (ACT == 1) {
#pragma unroll
                        for (int j = 0; j < 4; ++j) { v0[j] = gelu_tanh(v0[j]); v1[j] = gelu_tanh(v1[j]); } }
                    u32x4 w; w.x = cvt_pk_bf16(v0[0], v0[1]); w.y = cvt_pk_bf16(v0[2], v0[3]); w.z = cvt_pk_bf16(v1[0], v1[1]); w.w = cvt_pk_bf16(v1[2], v1[3]);
                    *(u32x4*)(rowp + bj * HALF) = w; } }
    }
};
struct EpiSwiglu {
    static constexpr bool PERM = true, AFTER_DRAIN = false;
    bf16_t* O; int ldc;
    __device__ __forceinline__ void operator()(const f32x4 (&acc)[2][2][4][2], const Unit& u, int wr, int wc, int fr, int fq) const {
        const int row0 = u.pm * BM + wr * 64 + fr, col0 = u.pn * HALF + wc * 32 + 8 * fq;
#pragma unroll
        for (int ai = 0; ai < 2; ++ai)
#pragma unroll
            for (int m = 0; m < 4; ++m) { bf16_t* rowp = O + (size_t)(row0 + ai * HALF + m * 16) * ldc + col0;
                f32x4 v0, v1;
#pragma unroll
                for (int j = 0; j < 4; ++j) { const float g0 = acc[ai][0][m][0][j], g1 = acc[ai][0][m][1][j];
                    v0[j] = g0 * acc[ai][1][m][0][j] * fast_rcp(1.0f + __builtin_amdgcn_exp2f(g0 * -1.4426950408889634f));
                    v1[j] = g1 * acc[ai][1][m][1][j] * fast_rcp(1.0f + __builtin_amdgcn_exp2f(g1 * -1.4426950408889634f)); }
                u32x4 w; w.x = cvt_pk_bf16(v0[0], v0[1]); w.y = cvt_pk_bf16(v0[2], v0[3]); w.z = cvt_pk_bf16(v1[0], v1[1]); w.w = cvt_pk_bf16(v1[2], v1[3]);
                *(u32x4*)rowp = w; }
    }
};
struct EpiResid {
    static constexpr bool PERM = false, AFTER_DRAIN = false;
    const float* in; const float* st; const float* g; const float* b; float* out; int ldc; float alpha;
    __device__ __forceinline__ void operator()(const f32x4 (&acc)[2][2][4][2], const Unit& u, int wr, int wc, int fr, int fq) const {
        const int row0 = u.pm * BM + wr * 64 + fr, col0 = u.pn * BM + wc * 32 + 4 * fq;
        f32x4 gv[2][2], bv[2][2];
        if (st) {
#pragma unroll
            for (int bj = 0; bj < 2; ++bj)
#pragma unroll
                for (int n = 0; n < 2; ++n) { gv[bj][n] = *(const f32x4*)(g + col0 + bj * HALF + n * 16); bv[bj][n] = *(const f32x4*)(b + col0 + bj * HALF + n * 16); } }
#pragma unroll
        for (int ai = 0; ai < 2; ++ai)
#pragma unroll
            for (int m = 0; m < 4; ++m) { const int row = row0 + ai * HALF + m * 16; const size_t off = (size_t)row * ldc + col0;
                float mean = 0.f, rstd = 1.f;
                if (st) { mean = st[2 * row]; rstd = st[2 * row + 1]; }
#pragma unroll
                for (int bj = 0; bj < 2; ++bj)
#pragma unroll
                    for (int n = 0; n < 2; ++n) { f32x4 x = *(const f32x4*)(in + off + bj * HALF + n * 16);
                        if (st) x = (x - mean) * rstd * gv[bj][n] + bv[bj][n];
                        *(f32x4*)(out + off + bj * HALF + n * 16) = x * alpha + acc[ai][bj][m][n]; } }
    }
};
}

typedef unsigned short bf16_t;
typedef short bf16x8 __attribute__((ext_vector_type(8)));
typedef float f32x4 __attribute__((ext_vector_type(4)));
typedef unsigned u32x4 __attribute__((ext_vector_type(4)));
typedef unsigned u32x2 __attribute__((ext_vector_type(2)));
#define LAS __attribute__((address_space(3)))
constexpr int DM = 1024, NB = 8, TS = 4096, MT = NB * TS, FF = 2816, EW = 2048;
constexpr float LN_EPS = 1e-5f, LNX_EPS = 64e-5f, ALPHA = 1.6817928305074290f;
constexpr int NWAVES = 8, NTHREADS = 512, LDS_BYTES = 147456;
constexpr size_t MiB = 1u << 20, M1 = 1u << 20;
constexpr size_t WS_W = 0, WS_VF = 120 * MiB, WS_XB = 184 * MiB, WS_BIG = 248 * MiB, WS_RK = 504 * MiB, WS_CTL = 508 * MiB, WS_ST = 509 * MiB, WS_END = 510 * MiB;
constexpr size_t WA_SZ = 4 * M1 + 2 * 327680, WA_RKV = 0, WA_OUT = 3 * M1, WA_L1T = 4 * M1, WA_L2W = WA_L1T + 327680, WA_L2A = WA_L2W + 65536, WA_L2V = WA_L2A + 65536, WA_L2G = WA_L2V + 32768;
constexpr size_t WB_OFF = 2 * WA_SZ, WB_SZ = 6 * M1 + 262144, WB_IN = 0, WB_OUT = 4 * M1, WB_WS = 6 * M1;
constexpr size_t WF_OFF = WB_OFF + 2 * WB_SZ, WF_GU = 0, WF_DN = (size_t)5632 * 1024, WF_SZ = WF_DN + (size_t)1024 * 2816;
static_assert((WF_OFF + 4 * WF_SZ) * 2 <= WS_VF, "weights fit");
constexpr size_t BIG_R = 0, BIG_K = 64 * MiB, BIG_V = 128 * MiB, BIG_LH = 192 * MiB, BIG_U = 0, BIG_VG = 128 * MiB, BIG_H = 0;

__device__ __forceinline__ unsigned pk2(float lo, float hi) { return pg8::cvt_pk_bf16(lo, hi); }
__device__ __forceinline__ float bf_lo(unsigned u) { return __uint_as_float(u << 16); }
__device__ __forceinline__ float bf_hi(unsigned u) { return __uint_as_float(u & 0xffff0000u); }
__device__ __forceinline__ f32x4 unpack4(u32x2 u) { return (f32x4){bf_lo(u.x), bf_hi(u.x), bf_lo(u.y), bf_hi(u.y)}; }
__device__ __forceinline__ u32x2 pack4(f32x4 v) { u32x2 r; r.x = pk2(v[0], v[1]); r.y = pk2(v[2], v[3]); return r; }
__device__ __forceinline__ bf16x8 pack8(f32x4 a, f32x4 b) { u32x4 w; w.x = pk2(a[0], a[1]); w.y = pk2(a[2], a[3]); w.z = pk2(b[0], b[1]); w.w = pk2(b[2], b[3]); return __builtin_bit_cast(bf16x8, w); }
__device__ __forceinline__ float wave_sum(float v) {
#pragma unroll
    for (int o = 1; o < 64; o <<= 1) v += __shfl_xor(v, o);
    return v;
}
using pg8::sigmoidf_;
__device__ __forceinline__ float tanhf_(float x) { return 1.0f - 2.0f * pg8::fast_rcp(1.0f + __expf(2.0f * x)); }
#define MFMA16(a, b, c) __builtin_amdgcn_mfma_f32_16x16x32_bf16((a), (b), (c), 0, 0, 0)

__device__ __forceinline__ void transpose_item(const float* W, int K, int N, bf16_t* WT, int mode, LAS float* scr, int item, int lane) {
    const int nblk = N / 32, kb = item / nblk, nb = item % nblk, k0 = 64 * kb, n0 = 32 * nb;
    int d0 = n0;
    if (mode == 1) { d0 = (n0 < FF) ? (256 * (n0 / 128) + (n0 % 128)) : (256 * ((n0 - FF) / 128) + 128 + ((n0 - FF) % 128)); }
#pragma unroll 8
    for (int i = 0; i < 32; ++i) { const int kk = 2 * i + (lane >> 5); scr[kk * 33 + (lane & 31)] = W[(size_t)(k0 + kk) * N + n0 + (lane & 31)]; }
    asm volatile("s_waitcnt lgkmcnt(0)" ::: "memory");
    const int c = lane & 7;
#pragma unroll
    for (int j = 0; j < 4; ++j) { const int n = (lane >> 3) + 8 * j; const LAS float* s = scr + (8 * c) * 33 + n;
        u32x4 o; o.x = pk2(s[0 * 33], s[1 * 33]); o.y = pk2(s[2 * 33], s[3 * 33]); o.z = pk2(s[4 * 33], s[5 * 33]); o.w = pk2(s[6 * 33], s[7 * 33]);
        *(u32x4*)(WT + (size_t)(d0 + n) * K + k0 + 8 * c) = o; }
    asm volatile("s_waitcnt lgkmcnt(0)" ::: "memory");
}
__device__ __forceinline__ void conv_big(const float* W, int K, int N, bf16_t* WT, int mode, LAS float* scr, int gw, int NGW, int& rot, int lane) {
    const int nitems = (K / 64) * (N / 32);
    int start = gw - (rot % NGW); if (start < 0) start += NGW;
    for (int it = start; it < nitems; it += NGW) transpose_item(W, K, N, WT, mode, scr, it, lane);
    rot += nitems;
}
struct In { const float* p[31]; };
__device__ __forceinline__ void phase_convert(const In& in, bf16_t* Wb, LAS unsigned char* lds) {
    int tid_ = threadIdx.x; asm volatile("" : "+v"(tid_)); const int tid = tid_, lane = tid & 63, wave = tid >> 6, gw = blockIdx.x * NWAVES + wave, NGW = gridDim.x * NWAVES;
    LAS float* scr = (LAS float*)(lds + wave * 16384);
    int rot = 0;
    for (int j = 0; j < 2; ++j) {
        for (int c = 0; c < 3; ++c) conv_big(in.p[2] + (size_t)(j * 3 + c) * M1, 1024, 1024, Wb + j * WA_SZ + WA_RKV + c * M1, 0, scr, gw, NGW, rot, lane);
        conv_big(in.p[19] + (size_t)j * M1, 1024, 1024, Wb + j * WA_SZ + WA_OUT, 0, scr, gw, NGW, rot, lane);
        conv_big(in.p[20] + (size_t)j * 4 * M1, 1024, 4096, Wb + WB_OFF + j * WB_SZ + WB_IN, 0, scr, gw, NGW, rot, lane);
        conv_big(in.p[26] + (size_t)j * 2 * M1, 2048, 1024, Wb + WB_OFF + j * WB_SZ + WB_OUT, 0, scr, gw, NGW, rot, lane);
    }
    for (int i = 0; i < 4; ++i) {
        conv_big(in.p[27] + (size_t)i * 1024 * 5632, 1024, 5632, Wb + WF_OFF + i * WF_SZ + WF_GU, 1, scr, gw, NGW, rot, lane);
        conv_big(in.p[28] + (size_t)i * 2816 * 1024, 2816, 1024, Wb + WF_OFF + i * WF_SZ + WF_DN, 0, scr, gw, NGW, rot, lane);
    }
    const int gt = blockIdx.x * NTHREADS + tid, NGT = gridDim.x * NTHREADS;
    for (int j = 0; j < 2; ++j) {
        bf16_t* L1T = Wb + j * WA_SZ + WA_L1T;
        for (int e = gt; e < 320 * 1024; e += NGT) { const int n = e >> 10, k = e & 1023; float v;
            if (n < 64) v = in.p[4][((size_t)j * 1024 + k) * 64 + n];
            else if (n < 128) v = in.p[7][((size_t)j * 1024 + k) * 64 + (n - 64)];
            else if (n < 160) v = (j > 0) ? in.p[10][((size_t)(j - 1) * 1024 + k) * 32 + (n - 128)] : 0.f;
            else v = in.p[12][((size_t)j * 1024 + k) * 160 + (n - 160)];
            L1T[(size_t)(k >> 5) * 10240 + n * 32 + (k & 31)] = (bf16_t)(pk2(v, 0.f) & 0xffffu); }
        bf16_t* L2W = Wb + j * WA_SZ + WA_L2W; bf16_t* L2A = Wb + j * WA_SZ + WA_L2A; bf16_t* L2V = Wb + j * WA_SZ + WA_L2V; bf16_t* L2G = Wb + j * WA_SZ + WA_L2G;
        for (int e = gt; e < 1024 * 64; e += NGT) { const int ch = e >> 6, k = e & 63;
            L2W[e] = (bf16_t)(pk2(in.p[5][((size_t)j * 64 + k) * 1024 + ch], 0.f) & 0xffffu);
            L2A[e] = (bf16_t)(pk2(in.p[8][((size_t)j * 64 + k) * 1024 + ch], 0.f) & 0xffffu); }
        for (int e = gt; e < 1024 * 32; e += NGT) { const int ch = e >> 5, k = e & 31;
            L2V[e] = (bf16_t)(pk2((j > 0) ? in.p[11][((size_t)(j - 1) * 32 + k) * 1024 + ch] : 0.f, 0.f) & 0xffffu); }
        for (int e = gt; e < 1024 * 160; e += NGT) { const int ch = e / 160, k = e % 160;
            L2G[e] = (bf16_t)(pk2(in.p[13][((size_t)j * 160 + k) * 1024 + ch], 0.f) & 0xffffu); }
        bf16_t* WSM = Wb + WB_OFF + j * WB_SZ + WB_WS;
        for (int e = gt; e < 16 * 128 * 128; e += NGT) { const int i = (e >> 7) & 127, jj = e & 127;
            WSM[e] = (bf16_t)(pk2((jj <= i) ? in.p[24][(size_t)j * 262144 + e] : 0.f, 0.f) & 0xffffu); }
    }
}

constexpr int P0_ROWB = 80, P0_SLAB = 320 * P0_ROWB;
__device__ __forceinline__ void phase_prep0(LAS unsigned char* lds, const float* xin, const float* mu, const bf16_t* L1S, bf16_t* XR, bf16_t* XK, bf16_t* XV, bf16_t* LH, bool has_v) {
    int tid_ = threadIdx.x; asm volatile("" : "+v"(tid_)); const int tid = tid_, lane = tid & 63, wave = tid >> 6, fr = lane & 15, fq = lane >> 4;
    LAS float* mus = (LAS float*)lds;
    LAS unsigned char* wb = lds + 24576;
    for (int e = tid; e < 6 * DM / 4; e += NTHREADS) *(LAS f32x4*)(mus + 4 * e) = *(const f32x4*)(mu + 4 * e);
    for (int blk = ((gridDim.x == 256) ? (int)((blockIdx.x & 7) * 32 + (blockIdx.x >> 3)) : (int)blockIdx.x); blk < MT / 128; blk += gridDim.x) {
        const int tok = blk * 128 + wave * 16 + fr; const bool first = (tok % TS) == 0;
        const float* xrow = xin + (size_t)tok * DM; const float* prow = xrow - DM;
        u32x4 wreg[3];
#pragma unroll
        for (int i = 0; i < 3; ++i) { const int q = tid + 512 * i; if (q < 1280) wreg[i] = *(const u32x4*)(L1S + (size_t)q * 8); }
#pragma unroll
        for (int i = 0; i < 3; ++i) { const int q = tid + 512 * i; if (q < 1280) *(LAS u32x4*)(wb + (q >> 2) * P0_ROWB + (q & 3) * 16) = wreg[i]; }
        __syncthreads();
        f32x4 acc[20];
#pragma unroll
        for (int j = 0; j < 20; ++j) acc[j] = (f32x4){0.f, 0.f, 0.f, 0.f};
        f32x4 nx0 = *(const f32x4*)(xrow + 8 * fq), nx1 = *(const f32x4*)(xrow + 8 * fq + 4), np0 = (f32x4){0.f, 0.f, 0.f, 0.f}, np1 = np0;
        if (!first) { np0 = *(const f32x4*)(prow + 8 * fq); np1 = *(const f32x4*)(prow + 8 * fq + 4); }
#pragma unroll 1
        for (int s = 0; s < 32; ++s) {
            const int c0 = 32 * s + 8 * fq;
            if (s + 1 < 32) {
#pragma unroll
                for (int i = 0; i < 3; ++i) { const int q = tid + 512 * i; if (q < 1280) wreg[i] = *(const u32x4*)(L1S + (size_t)(s + 1) * 10240 + (size_t)q * 8); } }
            const f32x4 x0 = nx0, x1 = nx1; f32x4 d0 = np0 - x0, d1 = np1 - x1;
            if (s + 1 < 32) { nx0 = *(const f32x4*)(xrow + c0 + 32); nx1 = *(const f32x4*)(xrow + c0 + 36);
                if (!first) { np0 = *(const f32x4*)(prow + c0 + 32); np1 = *(const f32x4*)(prow + c0 + 36); } }
#define MUV(i, o) (*(const LAS f32x4*)(mus + (i) * DM + c0 + (o)))
            *(bf16x8*)(XR + (size_t)tok * DM + c0) = pack8(x0 + d0 * MUV(0, 0), x1 + d1 * MUV(0, 4));
            *(bf16x8*)(XK + (size_t)tok * DM + c0) = pack8(x0 + d0 * MUV(2, 0), x1 + d1 * MUV(2, 4));
            const bf16x8 xw = pack8(x0 + d0 * MUV(1, 0), x1 + d1 * MUV(1, 4));
            const bf16x8 xv = pack8(x0 + d0 * MUV(3, 0), x1 + d1 * MUV(3, 4));
            if (XV) *(bf16x8*)(XV + (size_t)tok * DM + c0) = xv;
            const bf16x8 xa = pack8(x0 + d0 * MUV(4, 0), x1 + d1 * MUV(4, 4));
            const bf16x8 xg = pack8(x0 + d0 * MUV(5, 0), x1 + d1 * MUV(5, 4));
#undef MUV
            const LAS unsigned char* wsl = wb + (s & 1) * P0_SLAB + fr * P0_ROWB + fq * 16;
#pragma unroll
            for (int j = 0; j < 20; ++j) {
                if (has_v || (j != 8 && j != 9)) {
                    const bf16x8 wf = *(const LAS bf16x8*)(wsl + 16 * j * P0_ROWB);
                    acc[j] = MFMA16(wf, (j < 4) ? xw : (j < 8) ? xa : (j < 10) ? xv : xg, acc[j]);
                }
            }
            if (s + 1 < 32) {
#pragma unroll
                for (int i = 0; i < 3; ++i) { const int q = tid + 512 * i; if (q < 1280) *(LAS u32x4*)(wb + ((s + 1) & 1) * P0_SLAB + (q >> 2) * P0_ROWB + (q & 3) * 16) = wreg[i]; } }
            __syncthreads();
        }
#pragma unroll
        for (int j = 0; j < 20; ++j) { f32x4 v = acc[j];
            if (j < 4) { v[0] = tanhf_(v[0]); v[1] = tanhf_(v[1]); v[2] = tanhf_(v[2]); v[3] = tanhf_(v[3]); }
            if (j >= 10) { v[0] = sigmoidf_(v[0]); v[1] = sigmoidf_(v[1]); v[2] = sigmoidf_(v[2]); v[3] = sigmoidf_(v[3]); }
            *(u32x2*)(LH + (size_t)tok * 320 + 16 * j + 4 * fq) = pack4(v); }
    }
}
__device__ __forceinline__ void phase_shift(const float* xin, const float* mu, bf16_t* dst) {
    int tid_ = threadIdx.x; asm volatile("" : "+v"(tid_)); const int gt = blockIdx.x * NTHREADS + tid_, NGT = gridDim.x * NTHREADS;
    for (int i = gt; i < MT * 128; i += NGT) { const int tok = i >> 7, c0 = (i & 127) * 8;
        const float* xrow = xin + (size_t)tok * DM + c0;
        const f32x4 x0 = *(const f32x4*)xrow, x1 = *(const f32x4*)(xrow + 4);
        f32x4 d0 = (f32x4){0.f, 0.f, 0.f, 0.f}, d1 = d0;
        if ((tok % TS) != 0) { d0 = *(const f32x4*)(xrow - DM); d1 = *(const f32x4*)(xrow - DM + 4); }
        d0 = d0 - x0; d1 = d1 - x1;
        *(bf16x8*)(dst + (size_t)tok * DM + c0) = pack8(x0 + d0 * *(const f32x4*)(mu + c0), x1 + d1 * *(const f32x4*)(mu + c0 + 4)); }
}

__device__ __forceinline__ void phase_ln(const float* pre, const float* g, const float* b, float* xf, bf16_t* xb, float* stats) {
    int tid_ = threadIdx.x; asm volatile("" : "+v"(tid_)); const int tid = tid_, lane = tid & 63, wave = tid >> 6, gw = blockIdx.x * NWAVES + wave, NGW = gridDim.x * NWAVES;
    f32x4 gv[4], bv[4];
#pragma unroll
    for (int j = 0; j < 4; ++j) { gv[j] = *(const f32x4*)(g + 4 * lane + 256 * j); bv[j] = *(const f32x4*)(b + 4 * lane + 256 * j); }
    for (int row = gw; row < MT; row += NGW) {
        const float* xr = pre + (size_t)row * DM + 4 * lane;
        f32x4 v[4]; float s = 0.f;
#pragma unroll
        for (int j = 0; j < 4; ++j) { v[j] = *(const f32x4*)(xr + 256 * j); s += (v[j][0] + v[j][1]) + (v[j][2] + v[j][3]); }
        const float mean = wave_sum(s) * (1.f / DM); float s2 = 0.f;
#pragma unroll
        for (int j = 0; j < 4; ++j) { v[j] = v[j] - mean; s2 += (v[j][0] * v[j][0] + v[j][1] * v[j][1]) + (v[j][2] * v[j][2] + v[j][3] * v[j][3]); }
        const float rstd = __builtin_amdgcn_rsqf(wave_sum(s2) * (1.f / DM) + LN_EPS);
        if (stats && lane == 0) { stats[2 * row] = mean; stats[2 * row + 1] = rstd; }
#pragma unroll
        for (int j = 0; j < 4; ++j) { const f32x4 o = v[j] * rstd * gv[j] + bv[j];
            if (xf) *(f32x4*)(xf + (size_t)row * DM + 4 * lane + 256 * j) = o;
            if (xb) *(u32x2*)(xb + (size_t)row * DM + 4 * lane + 256 * j) = pack4(o); }
    }
}
constexpr int SC_TC = 32, SC_STEP = 356, SC_BUF = SC_TC * SC_STEP;
struct ScanP { const bf16_t* R; const bf16_t* K; bf16_t* V; const bf16_t* VF; const bf16_t* LH; const bf16_t* L2W; const bf16_t* L2A; const bf16_t* L2V;
               const float* w0; const float* a0; const float* v0; const float* k_k; const float* k_a; const float* r_k; bf16_t* Y; float* RK; };
__device__ __forceinline__ float red8(float x) {
    x += __int_as_float(__builtin_amdgcn_update_dpp(0, __float_as_int(x), 0xB1, 0xf, 0xf, true));
    x += __int_as_float(__builtin_amdgcn_update_dpp(0, __float_as_int(x), 0x4E, 0xf, 0xf, true));
    x += __int_as_float(__builtin_amdgcn_update_dpp(0, __float_as_int(x), 0x141, 0xf, 0xf, true));
    return x;
}
__device__ __forceinline__ void scan_produce(const ScanP& P, LAS float* buf, int tok, int srow, int h, int half, int cp, int fr, int fq, bool has_v) {
    const bf16_t* lh = P.LH + (size_t)tok * 320 + 8 * fq;
    const bf16x8 xw0 = *(const bf16x8*)(lh), xw1 = *(const bf16x8*)(lh + 32), xa0 = *(const bf16x8*)(lh + 64), xa1 = *(const bf16x8*)(lh + 96);
    float ss = 0.f, rk = 0.f; f32x4 kkq[2], bqq[2];
    const f32x4 z4 = (f32x4){0.f, 0.f, 0.f, 0.f};
    const bool own = cp == half;
    LAS float* p = buf + srow * SC_STEP + 4 * fq;
#pragma unroll
    for (int cc = 0; cc < 2; ++cc) {
        const int ct = 2 * cp + cc;
        const int crow = 64 * h + 16 * ct + fr, c = 64 * h + 16 * ct + 4 * fq;
        f32x4 aw = MFMA16(*(const bf16x8*)(P.L2W + (size_t)crow * 64 + 8 * fq), xw0, z4); aw = MFMA16(*(const bf16x8*)(P.L2W + (size_t)crow * 64 + 32 + 8 * fq), xw1, aw);
        f32x4 aa = MFMA16(*(const bf16x8*)(P.L2A + (size_t)crow * 64 + 8 * fq), xa0, z4); aa = MFMA16(*(const bf16x8*)(P.L2A + (size_t)crow * 64 + 32 + 8 * fq), xa1, aa);
        const f32x4 w0v = *(const f32x4*)(P.w0 + c), a0v = *(const f32x4*)(P.a0 + c), kkw = *(const f32x4*)(P.k_k + c), kaw = *(const f32x4*)(P.k_a + c), rkw = *(const f32x4*)(P.r_k + c);
        const f32x4 r4 = unpack4(*(const u32x2*)(P.R + (size_t)tok * DM + c)), k4 = unpack4(*(const u32x2*)(P.K + (size_t)tok * DM + c));
        if (own) {
            f32x4 v4 = unpack4(*(const u32x2*)(P.V + (size_t)tok * DM + c));
            if (has_v) {
                const bf16x8 xv0 = *(const bf16x8*)(lh + 128);
                const f32x4 an = MFMA16(*(const bf16x8*)(P.L2V + (size_t)crow * 32 + 8 * fq), xv0, z4);
                const f32x4 vf4 = unpack4(*(const u32x2*)(P.VF + (size_t)tok * DM + c)), v0v = *(const f32x4*)(P.v0 + c);
#pragma unroll
                for (int j = 0; j < 4; ++j) v4[j] = v4[j] + (vf4[j] - v4[j]) * sigmoidf_(v0v[j] + an[j]);
                *(u32x2*)(P.V + (size_t)tok * DM + c) = pack4(v4);
            }
            *(LAS f32x4*)(p + 320 + 16 * cc) = v4;
        }
        f32x4 dec, kkv, bq, kp;
#pragma unroll
        for (int j = 0; j < 4; ++j) {
            dec[j] = __expf(-0.60653065971263342f * sigmoidf_(w0v[j] + aw[j]));
            const float as = sigmoidf_(a0v[j] + aa[j]);
            const float kk = k4[j] * kkw[j]; kkv[j] = kk; bq[j] = kk * as; ss += kk * kk;
            const float kq = k4[j] * (1.0f + (as - 1.0f) * kaw[j]); kp[j] = kq;
            rk += r4[j] * kq * rkw[j];
        }
        *(LAS f32x4*)(p + 16 * ct) = dec;
        kkq[cc] = kkv; bqq[cc] = bq;
        *(LAS f32x4*)(p + 192 + 16 * ct) = kp;
        *(LAS f32x4*)(p + 256 + 16 * ct) = r4;
    }
#pragma unroll
    for (int cc = 0; cc < 2; ++cc) { const int c2 = 64 * h + 16 * (2 * (1 - cp) + cc) + 4 * fq;
        const f32x4 ko = unpack4(*(const u32x2*)(P.K + (size_t)tok * DM + c2)) * *(const f32x4*)(P.k_k + c2);
        ss += (ko[0] * ko[0] + ko[1] * ko[1]) + (ko[2] * ko[2] + ko[3] * ko[3]); }
    ss += __shfl_xor(ss, 16); ss += __shfl_xor(ss, 32);
    rk += __shfl_xor(rk, 16); rk += __shfl_xor(rk, 32);
    const float inv = 1.0f / fmaxf(sqrtf(ss), 1e-12f);
#pragma unroll
    for (int cc = 0; cc < 2; ++cc) { const int ct = 2 * cp + cc;
        *(LAS f32x4*)(p + 64 + 16 * ct) = kkq[cc] * (-inv);
        *(LAS f32x4*)(p + 128 + 16 * ct) = bqq[cc] * inv; }
    if (fq == 0) { if (half == 0) P.RK[((size_t)((tok / TS) * 16 + h) * 2 + cp) * TS + (tok % TS)] = rk; }
}
typedef float f32x2 __attribute__((ext_vector_type(2)));
struct ScanOps { f32x4 w0, w1, a0, a1, b0, b1, k0, k1, r0, r1; float v; };
__device__ __forceinline__ void scan_load(ScanOps& o, const LAS float* p, const LAS float* pv, const LAS float* pn) {
    o.w0 = *(const LAS f32x4*)(p); o.w1 = *(const LAS f32x4*)(p + 4); o.a0 = *(const LAS f32x4*)(p + 64); o.a1 = *(const LAS f32x4*)(p + 68);
    o.b0 = *(const LAS f32x4*)(p + 128); o.b1 = *(const LAS f32x4*)(p + 132); o.k0 = *(const LAS f32x4*)(p + 192); o.k1 = *(const LAS f32x4*)(p + 196);
    o.r0 = *(const LAS f32x4*)(p + 256); o.r1 = *(const LAS f32x4*)(p + 260);
    o.v = *pv; (void)pn;
}
#define LO2(v) ((f32x2){(v)[0], (v)[1]})
#define HI2(v) ((f32x2){(v)[2], (v)[3]})
__device__ __forceinline__ float scan_step(f32x2 (&S)[4], const ScanOps& o) {
    f32x2 t = S[0] * LO2(o.a0); t = S[1] * HI2(o.a0) + t; t = S[2] * LO2(o.a1) + t; t = S[3] * HI2(o.a1) + t;
    const float sa = red8(t[0] + t[1]);
    const f32x2 sa2 = (f32x2){sa, sa}, v2 = (f32x2){o.v, o.v};
    S[0] = S[0] * LO2(o.w0) + (sa2 * LO2(o.b0) + v2 * LO2(o.k0));
    S[1] = S[1] * HI2(o.w0) + (sa2 * HI2(o.b0) + v2 * HI2(o.k0));
    S[2] = S[2] * LO2(o.w1) + (sa2 * LO2(o.b1) + v2 * LO2(o.k1));
    S[3] = S[3] * HI2(o.w1) + (sa2 * HI2(o.b1) + v2 * HI2(o.k1));
    f32x2 y = S[0] * LO2(o.r0); y = S[1] * HI2(o.r0) + y; y = S[2] * LO2(o.r1) + y; y = S[3] * HI2(o.r1) + y;
    return red8(y[0] + y[1]);
}
__device__ __forceinline__ void phase_scan(const ScanP& P, LAS unsigned char* lds, bool has_v) {
    int tid_ = threadIdx.x; asm volatile("" : "+v"(tid_)); const int tid = tid_, lane = tid & 63, wave = __builtin_amdgcn_readfirstlane(tid >> 6), fr = lane & 15, fq = lane >> 4;
    LAS float* ring = (LAS float*)lds; LAS float* ybuf = ring + 2 * SC_BUF;
    const int row = (tid >> 3) & 31, cgi = tid & 7, cg8 = cgi * 8;
    const int pw = (wave - 4) & 3, ptt = pw & 1, pcp = pw >> 1, psr = 16 * ptt + fr;
    for (int unit = (gridDim.x == 256) ? (int)((blockIdx.x & 7) * 32 + (blockIdx.x >> 3)) : (int)blockIdx.x; unit < 256; unit += gridDim.x) {
        const int pair = unit >> 1, half = unit & 1, b = pair >> 4, h = pair & 15, m0 = b * TS;
        if (wave >= 4) scan_produce(P, ring, m0 + psr, psr, h, half, pcp, fr, fq, has_v);
        __syncthreads();
        f32x2 S2[4];
#pragma unroll
        for (int j = 0; j < 4; ++j) S2[j] = (f32x2){0.f, 0.f};
        float yk = 0.f;
        for (int c = 0; c < TS / SC_TC; ++c) {
            LAS float* buf = ring + (c & 1) * SC_BUF;
            if (wave < 4) {
                LAS float* yb = ybuf + (c & 1) * 1024;
                const LAS float* pb = buf + cg8;
                const LAS float* pv = buf + 320 + row;
                const LAS float* pn = buf + 352;
                ScanOps A, B;
                scan_load(A, pb, pv, pn);
#pragma unroll 1
                for (int s = 0; s < SC_TC; s += 8) {
#pragma unroll
                    for (int u = 0; u < 8; u += 2) {
                        scan_load(B, pb + (s + u + 1) * SC_STEP, pv + (s + u + 1) * SC_STEP, pn + (s + u + 1) * SC_STEP);
                        { const float y = scan_step(S2, A); yk = (cgi == u) ? y : yk; }
                        scan_load(A, pb + ((s + u + 2) & (SC_TC - 1)) * SC_STEP, pv + ((s + u + 2) & (SC_TC - 1)) * SC_STEP, pn + ((s + u + 2) & (SC_TC - 1)) * SC_STEP);
                        { const float y = scan_step(S2, B); yk = (cgi == u + 1) ? y : yk; }
                    }
                    yb[(s + cgi) * 32 + row] = yk;
                }
            } else if (c + 1 < TS / SC_TC) {
                scan_produce(P, ring + ((c + 1) & 1) * SC_BUF, m0 + (c + 1) * SC_TC + psr, psr, h, half, pcp, fr, fq, has_v);
            }
            __syncthreads();
            if (wave < 4) {
                const int step = tid >> 3, r4 = (tid & 7) * 4;
                const f32x4 yv = *(const LAS f32x4*)(ybuf + (c & 1) * 1024 + step * 32 + r4);
                *(u32x2*)(P.Y + (size_t)(m0 + c * SC_TC + step) * DM + 64 * h + 32 * half + r4) = pack4(yv);
            }
        }
        __syncthreads();
    }
}
constexpr int PO_ROWB = 336, PO_TILE = 64 * PO_ROWB;
__device__ __forceinline__ void phase_post(LAS unsigned char* lds, bf16_t* Y, const bf16_t* V, const float* RK, const bf16_t* LH, const bf16_t* L2G, const float* lnx_g, const float* lnx_b) {
    int tid_ = threadIdx.x; asm volatile("" : "+v"(tid_)); const int tid = tid_, lane = tid & 63, wave = tid >> 6, fr = lane & 15, fq = lane >> 4;
    for (int blk = ((gridDim.x == 256) ? (int)((blockIdx.x & 7) * 32 + (blockIdx.x >> 3)) : (int)blockIdx.x); blk < MT / 128; blk += gridDim.x) {
        const int tok = blk * 128 + wave * 16 + fr;
        bf16x8 xg[5];
#pragma unroll
        for (int kk = 0; kk < 5; ++kk) xg[kk] = *(const bf16x8*)(LH + (size_t)tok * 320 + 160 + 32 * kk + 8 * fq);
        u32x4 wreg[3];
#pragma unroll
        for (int i = 0; i < 3; ++i) { const int q = tid + 512 * i; if (q < 1280) wreg[i] = *(const u32x4*)(L2G + (size_t)q * 8); }
#pragma unroll
        for (int i = 0; i < 3; ++i) { const int q = tid + 512 * i; if (q < 1280) *(LAS u32x4*)(lds + (q / 20) * PO_ROWB + (q % 20) * 16) = wreg[i]; }
        __syncthreads();
#pragma unroll 1
        for (int h = 0; h < 16; ++h) {
            if (h + 1 < 16) {
#pragma unroll
                for (int i = 0; i < 3; ++i) { const int q = tid + 512 * i; if (q < 1280) wreg[i] = *(const u32x4*)(L2G + (size_t)(h + 1) * 10240 + (size_t)q * 8); } }
            const size_t rki = ((size_t)((tok / TS) * 16 + h) * 2) * TS + (tok % TS); const float rk = RK[rki] + RK[rki + TS];
            const LAS unsigned char* wt = lds + (h & 1) * PO_TILE + fq * 16;
            f32x4 yv[4], g[4]; float s = 0.f;
#pragma unroll
            for (int p = 0; p < 2; ++p) {
                const int c8 = 64 * h + 32 * p + 8 * fq;
#pragma unroll
                for (int t = 0; t < 2; ++t) {
                    const int lrow = 32 * p + 8 * (fr >> 2) + 4 * t + (fr & 3);
                    f32x4 acc = (f32x4){0.f, 0.f, 0.f, 0.f};
#pragma unroll
                    for (int kk = 0; kk < 5; ++kk) acc = MFMA16(*(const LAS bf16x8*)(wt + lrow * PO_ROWB + 64 * kk), xg[kk], acc);
                    g[2 * p + t] = acc; }
                const u32x4 yr = *(const u32x4*)(Y + (size_t)tok * DM + c8);
                yv[2 * p] = unpack4((u32x2){yr.x, yr.y}); yv[2 * p + 1] = unpack4((u32x2){yr.z, yr.w});
                s += (yv[2 * p][0] + yv[2 * p][1]) + (yv[2 * p][2] + yv[2 * p][3]) + (yv[2 * p + 1][0] + yv[2 * p + 1][1]) + (yv[2 * p + 1][2] + yv[2 * p + 1][3]);
            }
            s += __shfl_xor(s, 16); s += __shfl_xor(s, 32);
            const float mean = s * (1.f / 64.f); float q = 0.f;
#pragma unroll
            for (int ct = 0; ct < 4; ++ct) { yv[ct] = yv[ct] - mean; q += (yv[ct][0] * yv[ct][0] + yv[ct][1] * yv[ct][1]) + (yv[ct][2] * yv[ct][2] + yv[ct][3] * yv[ct][3]); }
            q += __shfl_xor(q, 16); q += __shfl_xor(q, 32);
            const float rstd = __builtin_amdgcn_rsqf(q * (1.f / 64.f) + LNX_EPS);
#pragma unroll
            for (int p = 0; p < 2; ++p) {
                const int c8 = 64 * h + 32 * p + 8 * fq;
                const u32x4 vr = *(const u32x4*)(V + (size_t)tok * DM + c8);
                const f32x4 o0 = (yv[2 * p] * rstd * *(const f32x4*)(lnx_g + c8) + *(const f32x4*)(lnx_b + c8) + unpack4((u32x2){vr.x, vr.y}) * rk) * g[2 * p];
                const f32x4 o1 = (yv[2 * p + 1] * rstd * *(const f32x4*)(lnx_g + c8 + 4) + *(const f32x4*)(lnx_b + c8 + 4) + unpack4((u32x2){vr.z, vr.w}) * rk) * g[2 * p + 1];
                u32x4 o; o.x = pk2(o0[0], o0[1]); o.y = pk2(o0[2], o0[3]); o.z = pk2(o1[0], o1[1]); o.w = pk2(o1[2], o1[3]);
                *(u32x4*)(Y + (size_t)tok * DM + c8) = o;
            }
            if (h + 1 < 16) {
#pragma unroll
                for (int i = 0; i < 3; ++i) { const int q = tid + 512 * i; if (q < 1280) *(LAS u32x4*)(lds + ((h + 1) & 1) * PO_TILE + (q / 20) * PO_ROWB + (q % 20) * 16) = wreg[i]; } }
            __syncthreads();
        }
    }
}
constexpr int SG_WRS = 272, SG_WT = 128 * SG_WRS;
constexpr int SG_RS = 260, SG_VN = 128 * SG_RS;
__device__ __forceinline__ void sgu_stage(LAS unsigned char* vn, const LAS float* st, const u32x4 (&raw)[4], const float* ln_g, const float* ln_b, int g, int tid) {
#pragma unroll
    for (int q = 0; q < 4; ++q) { const int idx = tid + 512 * q, tok = idx >> 4, ch8 = (idx & 15) * 8;
        const float mean = st[2 * tok], rstd = st[2 * tok + 1];
        const f32x4 g0 = *(const f32x4*)(ln_g + 128 * g + ch8), g1 = *(const f32x4*)(ln_g + 128 * g + ch8 + 4), b0 = *(const f32x4*)(ln_b + 128 * g + ch8), b1 = *(const f32x4*)(ln_b + 128 * g + ch8 + 4);
        const f32x4 n0 = (unpack4((u32x2){raw[q].x, raw[q].y}) - mean) * rstd * g0 + b0, n1 = (unpack4((u32x2){raw[q].z, raw[q].w}) - mean) * rstd * g1 + b1;
        LAS unsigned* d = (LAS unsigned*)(vn + tok * SG_RS + ch8 * 2);
        d[0] = pk2(n0[0], n0[1]); d[1] = pk2(n0[2], n0[3]); d[2] = pk2(n1[0], n1[1]); d[3] = pk2(n1[2], n1[3]); }
}
__device__ __forceinline__ void phase_sgu(LAS unsigned char* lds, bf16_t* U, const bf16_t* VG, const float* ln_g, const float* ln_b, const bf16_t* WSM, const float* b_s) {
    int tid_ = threadIdx.x; asm volatile("" : "+v"(tid_)); const int tid = tid_, lane = tid & 63, wave = __builtin_amdgcn_readfirstlane(tid >> 6), fr = lane & 15, fq = lane >> 4;
    LAS float* st = (LAS float*)lds; LAS unsigned char* vn0 = lds + 1024; LAS unsigned char* ws0 = vn0 + 2 * SG_VN;
    for (int unit = ((gridDim.x == 256) ? (int)((blockIdx.x & 7) * 32 + (blockIdx.x >> 3)) : (int)blockIdx.x); unit < MT / 128; unit += gridDim.x) {
        const size_t m0 = (size_t)unit * 128;
#pragma unroll 1
        for (int tk = 0; tk < 16; tk += 4) {
            float s1[4], s2[4];
#pragma unroll
            for (int r = 0; r < 4; ++r) { const bf16_t* rowp = VG + (m0 + 16 * wave + tk + r) * EW + 8 * lane; s1[r] = 0.f; s2[r] = 0.f;
#pragma unroll
                for (int q = 0; q < 4; ++q) { const u32x4 raw = *(const u32x4*)(rowp + 512 * q); const f32x4 a = unpack4((u32x2){raw.x, raw.y}), b = unpack4((u32x2){raw.z, raw.w});
                    s1[r] += (a[0] + a[1]) + (a[2] + a[3]) + (b[0] + b[1]) + (b[2] + b[3]);
                    s2[r] += (a[0] * a[0] + a[1] * a[1]) + (a[2] * a[2] + a[3] * a[3]) + (b[0] * b[0] + b[1] * b[1]) + (b[2] * b[2] + b[3] * b[3]); } }
#pragma unroll
            for (int o = 1; o < 64; o <<= 1) {
#pragma unroll
                for (int r = 0; r < 4; ++r) { s1[r] += __shfl_xor(s1[r], o); s2[r] += __shfl_xor(s2[r], o); } }
            if (lane == 0) {
#pragma unroll
                for (int r = 0; r < 4; ++r) { const float m = s1[r] * (1.f / EW); const float var = fmaxf(s2[r] * (1.f / EW) - m * m, 0.f);
                    st[2 * (16 * wave + tk + r)] = m; st[2 * (16 * wave + tk + r) + 1] = __builtin_amdgcn_rsqf(var + LN_EPS); } }
        }
        u32x4 raw[4];
#pragma unroll
        for (int q = 0; q < 4; ++q) { const int idx = tid + 512 * q; raw[q] = *(const u32x4*)(VG + (m0 + (idx >> 4)) * EW + (idx & 15) * 8); }
        u32x4 wsr[4];
#pragma unroll
        for (int q = 0; q < 4; ++q) { const int idx = tid + 512 * q; wsr[q] = *(const u32x4*)(WSM + (size_t)idx * 8); }
        __syncthreads();
        sgu_stage(vn0, st, raw, ln_g, ln_b, 0, tid);
#pragma unroll
        for (int q = 0; q < 4; ++q) { const int idx = tid + 512 * q; *(LAS u32x4*)(ws0 + (idx >> 4) * SG_WRS + (idx & 15) * 16) = wsr[q]; }
        __syncthreads();
#pragma unroll 1
        for (int g = 0; g < 16; ++g) {
            const LAS unsigned char* vn = vn0 + (g & 1) * SG_VN;
            if (g + 1 < 16) {
#pragma unroll
                for (int q = 0; q < 4; ++q) { const int idx = tid + 512 * q; raw[q] = *(const u32x4*)(VG + (m0 + (idx >> 4)) * EW + 128 * (g + 1) + (idx & 15) * 8); wsr[q] = *(const u32x4*)(WSM + (size_t)(g + 1) * 16384 + (size_t)idx * 8); } }
            const LAS unsigned char* wsl = ws0 + (g & 1) * SG_WT + fr * SG_WRS + fq * 16;
            const int cw = wave & 3, th = wave >> 2, c8 = 128 * g + 32 * cw + 8 * fq;
            u32x4 uraw[4]; float bias[4];
#pragma unroll
            for (int q = 0; q < 4; ++q) { const int tokl = 16 * (th + 2 * q) + fr; uraw[q] = *(const u32x4*)(U + (m0 + tokl) * EW + c8); bias[q] = b_s[g * 128 + tokl]; }
            bf16x8 af[2][4];
#pragma unroll
            for (int t = 0; t < 2; ++t)
#pragma unroll
                for (int s = 0; s < 4; ++s)
#pragma unroll
                    for (int e = 0; e < 8; ++e) af[t][s][e] = *(const LAS short*)(vn + (32 * s + 8 * fq + e) * SG_RS + (32 * cw + 8 * (fr >> 2) + 4 * t + (fr & 3)) * 2);
#pragma unroll
            for (int q = 0; q < 4; ++q) {
                const int tokl = 16 * (th + 2 * q) + fr;
                f32x4 acc0 = (f32x4){0.f, 0.f, 0.f, 0.f}, acc1 = acc0;
#pragma unroll
                for (int s = 0; s <= q; ++s) { const bf16x8 wf = *(const LAS bf16x8*)(wsl + 16 * (th + 2 * q) * SG_WRS + 64 * s);
                    acc0 = MFMA16(af[0][s], wf, acc0); acc1 = MFMA16(af[1][s], wf, acc1); }
                const f32x4 u0 = unpack4((u32x2){uraw[q].x, uraw[q].y}) * (acc0 + bias[q]), u1 = unpack4((u32x2){uraw[q].z, uraw[q].w}) * (acc1 + bias[q]);
                u32x4 o; o.x = pk2(u0[0], u0[1]); o.y = pk2(u0[2], u0[3]); o.z = pk2(u1[0], u1[1]); o.w = pk2(u1[2], u1[3]);
                *(u32x4*)(U + (m0 + tokl) * EW + c8) = o;
            }
            if (g + 1 < 16) sgu_stage(vn0 + ((g + 1) & 1) * SG_VN, st, raw, ln_g, ln_b, g + 1, tid);
            if (g + 1 < 16) {
#pragma unroll
                for (int q = 0; q < 4; ++q) { const int idx = tid + 512 * q; *(LAS u32x4*)(ws0 + ((g + 1) & 1) * SG_WT + (idx >> 4) * SG_WRS + (idx & 15) * 16) = wsr[q]; } }
            __syncthreads();
        }
    }
}
#define RLX_AGENT __ATOMIC_RELAXED, __HIP_MEMORY_SCOPE_AGENT
#define XB_TMO      128
#define XB_XCNT(j)  (256  + 64 * (j))
#define XB_XSUB(j)  (1280 + 64 * (j))
#define XB_XGEN(j)  (2304 + 64 * (j))
#define XB_TOP      3328
#define XB_TOPGEN   3392
#define XCD_BAR_WORDS 3456
#define XB_SPIN_CAP (1u << 18)

__device__ __forceinline__ unsigned xb_ld(unsigned* p)              { return __hip_atomic_load(p, __ATOMIC_RELAXED, __HIP_MEMORY_SCOPE_AGENT); }
__device__ __forceinline__ unsigned xb_add(unsigned* p, unsigned v) { return __hip_atomic_fetch_add(p, v, __ATOMIC_RELAXED, __HIP_MEMORY_SCOPE_AGENT); }
__device__ __forceinline__ unsigned xb_xcc_id() { return (unsigned)__builtin_amdgcn_s_getreg((3 << 11) | 20) & 0xFu; }
#define XB_SPIN(cond, bar) do { unsigned _sp = 0; while (cond) { __builtin_amdgcn_s_sleep(1); \
    if ((++_sp & 255u) == 0u) { if (xb_ld(&(bar)[XB_TMO])) break; if (_sp > XB_SPIN_CAP) { atomicAdd(&(bar)[XB_TMO], 1u); break; } } } } while (0)

struct XcdBarrier {
    unsigned* bar; unsigned x;
    volatile LAS unsigned* st;
};

__device__ __forceinline__ XcdBarrier xcd_barrier_post(unsigned* bar, volatile LAS unsigned* st) {
    XcdBarrier b; b.bar = bar; b.x = xb_xcc_id(); b.st = st;
    if (threadIdx.x == 0) (void)xb_add(&bar[XB_XCNT(b.x)], 1u);
    return b;
}
__device__ __forceinline__ void xcd_barrier_complete(unsigned* bar, unsigned x, unsigned& nloc, unsigned& nx) {
    const unsigned G = gridDim.x * gridDim.y * gridDim.z;
    unsigned sum, cnt, mine, sp = 0u;
    for (;;) {
        sum = 0u; cnt = 0u; mine = 0u;
#pragma unroll
        for (unsigned j = 0; j < 16; ++j) { const unsigned c = xb_ld(&bar[XB_XCNT(j)]); sum += c; cnt += (c > 0u) ? 1u : 0u; mine = (j == x) ? c : mine; }
        if (sum == G) break;
        __builtin_amdgcn_s_sleep(1);
        if ((++sp & 255u) == 0u) { if (xb_ld(&bar[XB_TMO])) break; if (sp > XB_SPIN_CAP) { atomicAdd(&bar[XB_TMO], 1u); break; } }
    }
    nloc = mine > 0u ? mine : 1u; nx = cnt > 0u ? cnt : 1u;
}

__device__ __forceinline__ void xcd_barrier(const XcdBarrier& b) {
    asm volatile("s_waitcnt vmcnt(0)" ::: "memory");
    __syncthreads();
    if (threadIdx.x == 0) {
        unsigned* bar = b.bar;
        __builtin_amdgcn_s_waitcnt(0);
        unsigned nloc = b.st[0], nx = b.st[1];
        if (nloc == 0u) { xcd_barrier_complete(bar, b.x, nloc, nx); b.st[0] = nloc; b.st[1] = nx; }
        const unsigned old = xb_add(&bar[XB_XSUB(b.x)], 1u);
        const unsigned gen = old / nloc;
        if (old + 1u == (gen + 1u) * nloc) {
            __builtin_amdgcn_fence(__ATOMIC_RELEASE, "agent");
            asm volatile("s_waitcnt vmcnt(0)" ::: "memory");
            const unsigned og = xb_add(&bar[XB_TOP], 1u);
            const unsigned tg = og / nx;
            if (og + 1u == (tg + 1u) * nx) xb_add(&bar[XB_TOPGEN], 1u);
            else XB_SPIN(xb_ld(&bar[XB_TOPGEN]) == tg, bar);
            __builtin_amdgcn_fence(__ATOMIC_ACQUIRE, "agent");
            xb_add(&bar[XB_XGEN(b.x)], 1u);
            asm volatile("s_waitcnt vmcnt(0)" ::: "memory");
        } else {
            XB_SPIN(xb_ld(&bar[XB_XGEN(b.x)]) == gen, bar);
            __builtin_amdgcn_fence(__ATOMIC_ACQUIRE, "agent");
            asm volatile("s_waitcnt vmcnt(0)" ::: "memory");
        }
    }
    __syncthreads();
}

struct Args { const float* in[31]; float* out; unsigned char* ws; int ph; int pad; };
constexpr int N_PHASES = 35;
#ifndef N_RUN
#define N_RUN 35
#endif
#ifndef PH_MASK
#define PH_MASK 0xffff
#endif
#define PHM(b) ((PH_MASK >> (b)) & 1)


#ifndef MK_MULTI
#define MK_MULTI 0
#endif

template <class Epi>
__device__ __forceinline__ void run_gemm(LAS unsigned char* lds, const bf16_t* A, const bf16_t* Bt, int N, int K, const Epi& E) {
    pg8::Gemm g{A, Bt, MT, N, K}; pg8::StaticOrder S; S.init(MT, N, (int)gridDim.x, (int)blockIdx.x);
    pg8::gemm_phase<Epi, pg8::StaticOrder, true, true>(lds, g, S, E);
}

__global__ void __launch_bounds__(NTHREADS) fwd_megakernel(Args args) {
    extern __shared__ __attribute__((aligned(16))) unsigned char lds_raw[];
    LAS unsigned char* lds = (LAS unsigned char*)lds_raw;
    cg::grid_group grid = cg::this_grid();
    const bool all = args.ph < 0; int cur = 0;
#define RUN (all || (cur++ == args.ph))
#define SEAM() do { if (all) xcd_barrier(xbar); } while (0)
    In in;
#pragma unroll
    for (int i = 0; i < 31; ++i) in.p[i] = args.in[i];
    unsigned char* ws = args.ws;
    bf16_t* Wb = (bf16_t*)(ws + WS_W);
    bf16_t* VF = (bf16_t*)(ws + WS_VF); bf16_t* XB = (bf16_t*)(ws + WS_XB);
    unsigned char* big = ws + WS_BIG;
    float* RK = (float*)(ws + WS_RK);
    float* XF = args.out; float* ST = (float*)(ws + WS_ST);

    unsigned* barw = (unsigned*)(ws + WS_CTL);
    volatile LAS unsigned* bst = (volatile LAS unsigned*)(lds + LDS_BYTES - 64);
    if (threadIdx.x < 2) bst[threadIdx.x] = 0u;
    if (PHM(0) && RUN) phase_convert(in, Wb, lds);
    XcdBarrier xbar; xbar.bar = barw; xbar.x = 0; xbar.st = bst;
    if (all) { xbar = xcd_barrier_post(barw, bst); SEAM(); }
    if (args.ph == -12345) grid.sync();
    for (int i = 0; i < 4; ++i) {
        const int j = i >> 1;
        const float* xin = (i == 0) ? in.p[0] : XF;
        const bf16_t* WF = Wb + WF_OFF + (size_t)i * WF_SZ;
        const bf16_t* mixA; const bf16_t* mixB; int mixK; const float* mixSt = nullptr;
        if ((i & 1) == 0) {
            const bool has_v = j > 0;
            const bf16_t* WA = Wb + (size_t)j * WA_SZ;
            const float* mu = in.p[1] + (size_t)j * 6 * DM;
            bf16_t* Rb = (bf16_t*)(big + BIG_R); bf16_t* Kb = (bf16_t*)(big + BIG_K); bf16_t* Vb = has_v ? (bf16_t*)(big + BIG_V) : VF; bf16_t* LH = (bf16_t*)(big + BIG_LH);
            bf16_t* XK2 = (bf16_t*)(big + BIG_V);
            bf16_t* XV2 = has_v ? nullptr : (bf16_t*)XF;
            if (PHM(1) && RUN) phase_prep0(lds, xin, mu, WA + WA_L1T, XB, XK2, XV2, LH, has_v);
            SEAM();
            if (PHM(3) && RUN) {
                const int nc = XV2 ? 3 : 2;
                for (int c = 0; c < nc; ++c) { pg8::EpiBf16<0> E{c == 0 ? Rb : (c == 1 ? Kb : Vb), DM, nullptr, 0, 0}; run_gemm(lds, c == 0 ? XB : (c == 1 ? XK2 : XV2), WA + WA_RKV + (size_t)c * M1, DM, DM, E); } }
            SEAM();
            if (!XV2) {
                if (PHM(2) && RUN) phase_shift(xin, mu + 3 * DM, XB);
                SEAM();
                if (PHM(3) && RUN) { pg8::EpiBf16<0> E{Vb, DM, nullptr, 0, 0}; run_gemm(lds, XB, WA + WA_RKV + (size_t)2 * M1, DM, DM, E); }
                SEAM();
            }
            if (PHM(4) && RUN) { ScanP P{Rb, Kb, Vb, VF, LH, WA + WA_L2W, WA + WA_L2A, WA + WA_L2V, in.p[3] + j * DM, in.p[6] + j * DM, in.p[9] + (has_v ? (j - 1) * DM : 0), in.p[14] + j * DM, in.p[15] + j * DM, in.p[16] + j * DM, XB, RK};
                phase_scan(P, lds, has_v);
            }
            SEAM();
                        if (PHM(5) && RUN) phase_post(lds, XB, Vb, RK, LH, WA + WA_L2G, in.p[17] + j * DM, in.p[18] + j * DM);
            SEAM();
            mixA = XB; mixB = WA + WA_OUT; mixK = DM;
        } else {
            const bf16_t* WB = Wb + WB_OFF + (size_t)j * WB_SZ;
            bf16_t* U = (bf16_t*)(big + BIG_U); bf16_t* VG = (bf16_t*)(big + BIG_VG);
            if (PHM(6) && RUN) { pg8::EpiBf16<1> E{U, EW, in.p[21] + (size_t)j * 2 * EW, EW, (size_t)MT * EW}; run_gemm(lds, XB, WB + WB_IN, 2 * EW, DM, E); }
            SEAM();
                        if (PHM(7) && RUN) phase_sgu(lds, U, VG, in.p[22] + j * EW, in.p[23] + j * EW, WB + WB_WS, in.p[25] + j * 2048);
            SEAM();
            mixA = U; mixB = WB + WB_OUT; mixK = EW; mixSt = ST;
        }
        if (PHM(8) && RUN) { pg8::EpiResid E{xin, mixSt, in.p[29] + (size_t)(2 * i - 1) * DM, in.p[30] + (size_t)(2 * i - 1) * DM, XF, DM, ALPHA}; run_gemm(lds, mixA, mixB, DM, mixK, E); }
        SEAM();
        if (PHM(9) && RUN) phase_ln(XF, in.p[29] + (size_t)(2 * i) * DM, in.p[30] + (size_t)(2 * i) * DM, nullptr, XB, ST);
        SEAM();
        bf16_t* H = (bf16_t*)(big + BIG_H);
        if (PHM(10) && RUN) { pg8::EpiSwiglu E{H, FF}; run_gemm(lds, XB, WF + WF_GU, 2 * FF, DM, E);
        }
        SEAM();
        if (PHM(11) && RUN) { pg8::EpiResid E{XF, ST, in.p[29] + (size_t)(2 * i) * DM, in.p[30] + (size_t)(2 * i) * DM, XF, DM, ALPHA};
            run_gemm(lds, H, WF + WF_DN, DM, FF, E); }
        SEAM();
        if (PHM(12) && RUN) phase_ln(XF, in.p[29] + (size_t)(2 * i + 1) * DM, in.p[30] + (size_t)(2 * i + 1) * DM, (i & 1) ? XF : nullptr, (i & 1) ? nullptr : XB, ST);
        if (i < 3) SEAM();
    }
#undef RUN
#undef SEAM
}

extern "C" void kernel_launch(void* const* d_in, const int* in_sizes, int n_in, void* d_out, int out_size, void* d_ws, size_t ws_size, hipStream_t stream) {
    static int grid = 0;
    if (grid == 0) {
        if (n_in != 31 || out_size != MT * DM || ws_size < WS_END) { fprintf(stderr, "kernel_launch: unexpected shapes: n_in %d out %d ws %zu\n", n_in, out_size, ws_size); grid = -1; return; }
        int dev = 0, cus = 0, per_cu = 0;
        hipGetDevice(&dev); hipDeviceGetAttribute(&cus, hipDeviceAttributeMultiprocessorCount, dev);
        if (hipFuncSetAttribute((const void*)fwd_megakernel, hipFuncAttributeMaxDynamicSharedMemorySize, LDS_BYTES) != hipSuccess) { fprintf(stderr, "kernel_launch: hipFuncSetAttribute failed\n"); grid = -1; return; }
        if (hipOccupancyMaxActiveBlocksPerMultiprocessor(&per_cu, (const void*)fwd_megakernel, NTHREADS, LDS_BYTES) != hipSuccess || per_cu < 1) { fprintf(stderr, "kernel_launch: occupancy query gave %d\n", per_cu); per_cu = 1; }
        (void)hipGetLastError();
        grid = cus * per_cu;
        fprintf(stderr, "kernel_launch: grid %d (cus %d x %d)\n", grid, cus, per_cu);
    }
    if (grid < 0) return;
    if (hipMemsetAsync((unsigned char*)d_ws + WS_CTL, 0, 16384, stream) != hipSuccess) { fprintf(stderr, "kernel_launch: hipMemsetAsync failed\n"); return; }
    Args a{};
    for (int i = 0; i < 31; ++i) a.in[i] = (const float*)d_in[i];
    a.out = (float*)d_out; a.ws = (unsigned char*)d_ws; a.pad = 0;
#if MK_MULTI
    for (int ph = 0; ph < N_RUN; ++ph) { a.ph = ph; hipLaunchKernelGGL(fwd_megakernel, dim3(grid), dim3(NTHREADS), LDS_BYTES, stream, a); }
#else
    a.ph = -1;
    void* kargs[] = {&a};
    hipError_t e = hipLaunchCooperativeKernel((const void*)fwd_megakernel, dim3(grid), dim3(NTHREADS), kargs, LDS_BYTES, stream);
    if (e != hipSuccess) fprintf(stderr, "cooperative launch failed: %s (grid %d)\n", hipGetErrorString(e), grid);
#endif
}
```

```cpp
#include <hip/hip_runtime.h>
#include <hip/hip_cooperative_groups.h>
#include <cstdio>
namespace cg = cooperative_groups;

namespace pg8 {
#define PG8_LAS __attribute__((address_space(3)))
typedef unsigned short bf16_t;
typedef short bf16x8 __attribute__((ext_vector_type(8)));
typedef float f32x4 __attribute__((ext_vector_type(4)));
typedef unsigned u32x4 __attribute__((ext_vector_type(4)));
constexpr int BM = 256, BK = 64, HALF = 128, HTB = HALF * BK * 2  , STAGE_BYTES = 8 * HTB, NXCD = 8, WGM = 4;

__host__ __device__ __forceinline__ int lds_byte(int r, int c) { const int st = (r >> 4) * 2 + (c >> 5), rr = r & 15, cc = c & 31, ob = rr * 64 + cc * 2; return st * 1024 + (ob ^ (((ob >> 9) & 1) << 5)); }
__host__ __device__ __forceinline__ void stage_rc(int b, int& R, int& C) { const int st = b / 1024, sb = b % 1024, swz = sb ^ (((sb >> 9) & 1) << 5); R = (st >> 1) * 16 + swz / 64; C = (st & 1) * 32 + (swz % 64) / 2; }
__host__ __device__ __forceinline__ int perm32(int rho) { const int n = rho >> 4, i = rho & 15; return 8 * (i >> 2) + 4 * n + (i & 3); }

struct Unit { int pm, pn; };
struct Gemm { const bf16_t* A; const bf16_t* Bt; int M, N, K; };

struct StaticOrder {
    int nM, nN, nwg, G, c;
    __host__ __device__ void init(int M, int N, int G_, int c_) { nM = M / BM; nN = N / BM; nwg = nM * nN; G = G_; c = c_; }
    __host__ __device__ bool next(int i, Unit& u) const {
        const long L = (long)i * G + c; if (L >= nwg) return false;
        int wgid = (int)L; { const int q = nwg / NXCD, r = nwg % NXCD, xcd = wgid % NXCD, off = wgid / NXCD; wgid = (xcd < r ? xcd * (q + 1) : r * (q + 1) + (xcd - r) * q) + off; }
        const int wgm = (nN <= 4) ? 8 : WGM;
        const int nig = wgm * nN, gid = wgid / nig, fm = gid * wgm, gsz = (nM - fm) < wgm ? (nM - fm) : wgm;
        u.pm = fm + ((wgid % nig) % gsz); u.pn = (wgid % nig) / gsz; return true;
    }
    __device__ __forceinline__ void a_ready(const Unit&) const {}
    __device__ __forceinline__ void done(const Unit&) const {}
};

template <class Epi, class Sched, bool ALIGN_EPI = false, bool SP2 = false>
__device__ __forceinline__ void gemm_phase(PG8_LAS unsigned char* lds, const Gemm g, const Sched& S, const Epi& E) {
    int tid_ = threadIdx.x; asm volatile("" : "+v"(tid_)); const int tid = tid_, wid = __builtin_amdgcn_readfirstlane(tid >> 6), lane = tid & 63, wr = wid >> 2, wc = wid & 3, fr = lane & 15, fq = lane >> 4;
    const int K = g.K, nt = K / BK;
    unsigned voffA[2], voffB[2];
#pragma unroll
    for (int i = 0; i < 2; ++i) { int R, C; stage_rc(tid * 16 + i * 8192, R, C); const int Rb = Epi::PERM ? ((R & ~31) + perm32(R & 31)) : R;
        voffA[i] = (unsigned)(R * K + C) * 2u; voffB[i] = (unsigned)(Rb * K + C) * 2u; }
    const size_t kstep = (size_t)(BK * 2);
    const size_t hstep = (size_t)HALF * K * 2;
    const size_t tstep = 2 * hstep;
    const unsigned ldsw = (unsigned)wid * 1024u;
    const int aoff = lds_byte(wr * 64 + fr, fq * 8), boff = lds_byte(wc * 32 + fr, fq * 8);
#define PG8_SA(b, h) (((b) * 2 + (h)) * HTB)
#define PG8_SB(b, h) ((4 + (b) * 2 + (h)) * HTB)
#define PG8_STAGE(bufoff, gbase, voff) do { _Pragma("unroll") for (int _i = 0; _i < 2; ++_i) \
        __builtin_amdgcn_global_load_lds((const unsigned*)((const char*)(gbase) + (voff)[_i]), (PG8_LAS unsigned*)(lds + (bufoff) + ldsw + _i * 8192), 16, 0, 0); } while (0)
#define PG8_LDA(dst, b, h) do { _Pragma("unroll") for (int m = 0; m < 4; ++m) _Pragma("unroll") for (int k = 0; k < 2; ++k) dst[m][k] = *(const PG8_LAS bf16x8*)(lds + PG8_SA(b, h) + aoff + m * 2048 + k * 1024); } while (0)
#define PG8_LDB(dst, b, h) do { _Pragma("unroll") for (int n = 0; n < 2; ++n) _Pragma("unroll") for (int k = 0; k < 2; ++k) dst[n][k] = *(const PG8_LAS bf16x8*)(lds + PG8_SB(b, h) + boff + n * 2048 + k * 1024); } while (0)
#define PG8_MMA(ai, bj, At, Bt) do { __builtin_amdgcn_s_setprio(1); _Pragma("unroll") for (int m = 0; m < 4; ++m) _Pragma("unroll") for (int n = 0; n < 2; ++n) _Pragma("unroll") for (int k = 0; k < 2; ++k) \
        acc[ai][bj][m][n] = __builtin_amdgcn_mfma_f32_16x16x32_bf16(Bt[n][k], At[m][k], acc[ai][bj][m][n], 0, 0, 0); __builtin_amdgcn_s_setprio(0); } while (0)
#define PG8_WAIT_V(n) asm volatile("s_waitcnt vmcnt(" #n ")" ::: "memory")
#define PG8_WAIT_L(n) asm volatile("s_waitcnt lgkmcnt(" #n ")" ::: "memory")
#define PG8_BAR __builtin_amdgcn_s_barrier()
#define PG8_SCHED __builtin_amdgcn_sched_barrier(0)
    Unit cur, nxt; int ui = 0;
    if (!S.next(0, cur)) return;
    f32x4 acc[2][2][4][2];
#pragma unroll
    for (int a = 0; a < 2; ++a)
#pragma unroll
        for (int b = 0; b < 2; ++b)
#pragma unroll
            for (int m = 0; m < 4; ++m)
#pragma unroll
                for (int n = 0; n < 2; ++n) acc[a][b][m][n] = (f32x4){0.f, 0.f, 0.f, 0.f};
    bf16x8 At[4][2], B0[2][2], B1[2][2];
    const char* cA = (const char*)g.A + (size_t)cur.pm * tstep; const char* cB = (const char*)g.Bt + (size_t)cur.pn * tstep;
    S.a_ready(cur);
    if constexpr (SP2) {
        PG8_STAGE(PG8_SB(0, 0), cB, voffB); PG8_STAGE(PG8_SB(0, 1), cB + hstep, voffB); PG8_STAGE(PG8_SA(0, 0), cA, voffA); PG8_STAGE(PG8_SA(0, 1), cA + hstep, voffA);
        if (wr == 1) PG8_BAR;
        PG8_WAIT_V(2); PG8_BAR;
        PG8_STAGE(PG8_SB(1, 0), cB + kstep, voffB); PG8_STAGE(PG8_SA(1, 0), cA + kstep, voffA); PG8_STAGE(PG8_SB(1, 1), cB + hstep + kstep, voffB);
        PG8_WAIT_V(6); PG8_BAR;
    } else {
        PG8_STAGE(PG8_SB(0, 0), cB, voffB); PG8_STAGE(PG8_SA(0, 0), cA, voffA); PG8_STAGE(PG8_SB(0, 1), cB + hstep, voffB); PG8_STAGE(PG8_SA(0, 1), cA + hstep, voffA);
        if (wr == 1) PG8_BAR;
        PG8_WAIT_V(4); PG8_BAR;
        PG8_STAGE(PG8_SB(1, 0), cB + kstep, voffB); PG8_STAGE(PG8_SA(1, 0), cA + kstep, voffA); PG8_STAGE(PG8_SB(1, 1), cB + hstep + kstep, voffB);
        PG8_WAIT_V(6); PG8_BAR;
    }
    for (;;) {
        const bool has_next = S.next(ui + 1, nxt);
        const char* nA = has_next ? (const char*)g.A + (size_t)nxt.pm * tstep : cA; const char* nB = has_next ? (const char*)g.Bt + (size_t)nxt.pn * tstep : cB;
        for (int t = 0; t < nt; t += 2) {
            const bool last = (t == nt - 2);
            const char* a1 = cA + (size_t)(t + 1) * kstep;
            const char* a2 = last ? nA : cA + (size_t)(t + 2) * kstep; const char* b2 = last ? nB : cB + (size_t)(t + 2) * kstep;
            const char* a3 = a2 + kstep; const char* b3 = b2 + kstep;
            if (last && has_next) S.a_ready(nxt);
            if constexpr (SP2) {
            PG8_LDB(B0, 0, 0); PG8_LDB(B1, 0, 1); PG8_SCHED; PG8_LDA(At, 0, 0); PG8_STAGE(PG8_SA(1, 1), a1 + hstep, voffA);
            PG8_WAIT_V(8); PG8_WAIT_L(0); PG8_BAR; PG8_MMA(0, 0, At, B0); PG8_MMA(0, 1, At, B1); PG8_BAR; PG8_SCHED;
            PG8_LDA(At, 0, 1); PG8_STAGE(PG8_SB(0, 0), b2, voffB); PG8_STAGE(PG8_SB(0, 1), b2 + hstep, voffB); PG8_STAGE(PG8_SA(0, 0), a2, voffA);
            PG8_WAIT_V(8); PG8_WAIT_L(0); PG8_BAR; PG8_MMA(1, 0, At, B0); PG8_MMA(1, 1, At, B1); PG8_BAR; PG8_SCHED;
            PG8_LDB(B0, 1, 0); PG8_LDB(B1, 1, 1); PG8_SCHED; PG8_LDA(At, 1, 0); PG8_STAGE(PG8_SA(0, 1), a2 + hstep, voffA);
            PG8_WAIT_V(8); PG8_WAIT_L(0); PG8_BAR; PG8_MMA(0, 0, At, B0); PG8_MMA(0, 1, At, B1); PG8_BAR; PG8_SCHED;
            PG8_LDA(At, 1, 1); PG8_STAGE(PG8_SB(1, 0), b3, voffB); PG8_STAGE(PG8_SB(1, 1), b3 + hstep, voffB); PG8_STAGE(PG8_SA(1, 0), a3, voffA);
            PG8_WAIT_V(8); PG8_WAIT_L(0); PG8_BAR; PG8_MMA(1, 0, At, B0); PG8_MMA(1, 1, At, B1); PG8_BAR; PG8_SCHED;
            } else {
            PG8_LDB(B0, 0, 0); PG8_SCHED; PG8_LDA(At, 0, 0); PG8_STAGE(PG8_SA(1, 1), a1 + hstep, voffA);
            PG8_WAIT_L(8); PG8_BAR; PG8_WAIT_L(0); PG8_MMA(0, 0, At, B0); PG8_BAR; PG8_SCHED;
            PG8_LDB(B1, 0, 1); PG8_STAGE(PG8_SB(0, 0), b2, voffB);
            PG8_BAR; PG8_WAIT_L(0); PG8_MMA(0, 1, At, B1); PG8_BAR;
            PG8_LDA(At, 0, 1); PG8_STAGE(PG8_SA(0, 0), a2, voffA);
            PG8_BAR; PG8_WAIT_L(0); PG8_MMA(1, 0, At, B0); PG8_BAR; PG8_SCHED;
            PG8_STAGE(PG8_SB(0, 1), b2 + hstep, voffB);
            PG8_WAIT_V(6); PG8_BAR; PG8_MMA(1, 1, At, B1); PG8_BAR;
            PG8_LDB(B0, 1, 0); PG8_SCHED; PG8_LDA(At, 1, 0); PG8_STAGE(PG8_SA(0, 1), a2 + hstep, voffA);
            PG8_WAIT_L(8); PG8_BAR; PG8_WAIT_L(0); PG8_MMA(0, 0, At, B0); PG8_BAR; PG8_SCHED;
            PG8_LDB(B1, 1, 1); PG8_STAGE(PG8_SB(1, 0), b3, voffB);
            PG8_BAR; PG8_WAIT_L(0); PG8_MMA(0, 1, At, B1); PG8_BAR;
            PG8_LDA(At, 1, 1); PG8_STAGE(PG8_SA(1, 0), a3, voffA);
            PG8_BAR; PG8_WAIT_L(0); PG8_MMA(1, 0, At, B0); PG8_BAR; PG8_SCHED;
            PG8_STAGE(PG8_SB(1, 1), b3 + hstep, voffB);
            PG8_WAIT_V(6); PG8_BAR; PG8_MMA(1, 1, At, B1); PG8_BAR;
            }
        }
        if constexpr (ALIGN_EPI) { if (wr == 0) PG8_BAR; }
        if constexpr (!Epi::AFTER_DRAIN) { E(acc, cur, wr, wc, fr, fq); S.done(cur); }
        if (!has_next) break;
#pragma unroll
        for (int a = 0; a < 2; ++a)
#pragma unroll
            for (int b = 0; b < 2; ++b)
#pragma unroll
                for (int m = 0; m < 4; ++m)
#pragma unroll
                    for (int n = 0; n < 2; ++n) acc[a][b][m][n] = (f32x4){0.f, 0.f, 0.f, 0.f};
        cur = nxt; cA = nA; cB = nB; ++ui;
        if constexpr (ALIGN_EPI) { if (wr == 1) PG8_BAR; }
    }
    PG8_WAIT_V(0);
    if constexpr (!ALIGN_EPI) { if (wr == 0) PG8_BAR; }
    PG8_BAR;
    if constexpr (Epi::AFTER_DRAIN) { E.fused(acc, cur, wr, wc, fr, fq, lds, wid, lane); S.done(cur); }
#undef PG8_SA
#undef PG8_SB
#undef PG8_STAGE
#undef PG8_LDA
#undef PG8_LDB
#undef PG8_MMA
#undef PG8_WAIT_V
#undef PG8_WAIT_L
#undef PG8_BAR
#undef PG8_SCHED
}
typedef float f32x2_t __attribute__((ext_vector_type(2)));
typedef __bf16 bf16x2_t __attribute__((ext_vector_type(2)));
__device__ __forceinline__ unsigned cvt_pk_bf16(float lo, float hi) { f32x2_t v = {lo, hi}; bf16x2_t b = __builtin_convertvector(v, bf16x2_t); return __builtin_bit_cast(unsigned, b); }
__device__ __forceinline__ float fast_rcp(float x) { return __builtin_amdgcn_rcpf(x); }
__device__ __forceinline__ float sigmoidf_(float x) { return fast_rcp(1.0f + __expf(-x)); }
__device__ __forceinline__ float gelu_tanh(float x) { const float t = x * __builtin_fmaf(x * x, -0.10294324f, -2.3022082f);
    return x * fast_rcp(1.0f + __builtin_amdgcn_exp2f(t)); }

template <int ACT  > struct EpiBf16 {
    static constexpr bool PERM = true, AFTER_DRAIN = false;
    bf16_t* O; int ldc; const float* bias; int split_cols; size_t split_stride;
    __device__ __forceinline__ void operator()(const f32x4 (&acc)[2][2][4][2], const Unit& u, int wr, int wc, int fr, int fq) const {
        const int row0 = u.pm * BM + wr * 64 + fr; int colt = u.pn * BM; bf16_t* base = O;
        if (split_cols) { const int t = colt / split_cols; base += (size_t)t * split_stride; colt -= t * split_cols; }
        const int col0 = colt + wc * 32 + 8 * fq, bcol0 = u.pn * BM + wc * 32 + 8 * fq;
        f32x4 bv[2][2];
#pragma unroll
        for (int bj = 0; bj < 2; ++bj)
#pragma unroll
            for (int n = 0; n < 2; ++n) bv[bj][n] = (ACT == 1) ? *(const f32x4*)(bias + bcol0 + bj * HALF + 4 * n) : (f32x4){0.f, 0.f, 0.f, 0.f};
#pragma unroll
        for (int ai = 0; ai < 2; ++ai)
#pragma unroll
            for (int m = 0; m < 4; ++m) { bf16_t* rowp = base + (size_t)(row0 + ai * HALF + m * 16) * ldc + col0;
#pragma unroll
                for (int bj = 0; bj < 2; ++bj) { f32x4 v0 = acc[ai][bj][m][0] + bv[bj][0], v1 = acc[ai][bj][m][1] + bv[bj][1];
                    if (ACT == 1) {
#pragma unroll
                        for (int j = 0; j < 4; ++j) { v0[j] = gelu_tanh(v0[j]); v1[j] = gelu_tanh(v1[j]); } }
                    u32x4 w; w.x = cvt_pk_bf16(v0[0], v0[1]); w.y = cvt_pk_bf16(v0[2], v0[3]); w.z = cvt_pk_bf16(v1[0], v1[1]); w.w = cvt_pk_bf16(v1[2], v1[3]);
                    *(u32x4*)(rowp + bj * HALF) = w; } }
    }
};
struct EpiSwiglu {
    static constexpr bool PERM = true, AFTER_DRAIN = false;
    bf16_t* O; int ldc;
    __device__ __forceinline__ void operator()(const f32x4 (&acc)[2][2][4][2], const Unit& u, int wr, int wc, int fr, int fq) const {
        const int row0 = u.pm * BM + wr * 64 + fr, col0 = u.pn * HALF + wc * 32 + 8 * fq;
#pragma unroll
        for (int ai = 0; ai < 2; ++ai)
#pragma unroll
            for (int m = 0; m < 4; ++m) { bf16_t* rowp = O + (size_t)(row0 + ai * HALF + m * 16) * ldc + col0;
                f32x4 v0, v1;
#pragma unroll
                for (int j = 0; j < 4; ++j) { const float g0 = acc[ai][0][m][0][j], g1 = acc[ai][0][m][1][j];
                    v0[j] = g0 * acc[ai][1][m][0][j] * fast_rcp(1.0f + __builtin_amdgcn_exp2f(g0 * -1.4426950408889634f));
                    v1[j] = g1 * acc[ai][1][m][1][j] * fast_rcp(1.0f + __builtin_amdgcn_exp2f(g1 * -1.4426950408889634f)); }
                u32x4 w; w.x = cvt_pk_bf16(v0[0], v0[1]); w.y = cvt_pk_bf16(v0[2], v0[3]); w.z = cvt_pk_bf16(v1[0], v1[1]); w.w = cvt_pk_bf16(v1[2], v1[3]);
                *(u32x4*)rowp = w; }
    }
};
struct EpiResid {
    static constexpr bool PERM = false, AFTER_DRAIN = false;
    const float* in; const float* st; const float* g; const float* b; float* out; int ldc; float alpha;
    __device__ __forceinline__ void operator()(const f32x4 (&acc)[2][2][4][2], const Unit& u, int wr, int wc, int fr, int fq) const {
        const int row0 = u.pm * BM + wr * 64 + fr, col0 = u.pn * BM + wc * 32 + 4 * fq;
        f32x4 gv[2][2], bv[2][2];
        if (st) {
#pragma unroll
            for (int bj = 0; bj < 2; ++bj)
#pragma unroll
                for (int n = 0; n < 2; ++n) { gv[bj][n] = *(const f32x4*)(g + col0 + bj * HALF + n * 16); bv[bj][n] = *(const f32x4*)(b + col0 + bj * HALF + n * 16); } }
#pragma unroll
        for (int ai = 0; ai < 2; ++ai)
#pragma unroll
            for (int m = 0; m < 4; ++m) { const int row = row0 + ai * HALF + m * 16; const size_t off = (size_t)row * ldc + col0;
                float mean = 0.f, rstd = 1.f;
                if (st) { mean = st[2 * row]; rstd = st[2 * row + 1]; }
#pragma unroll
                for (int bj = 0; bj < 2; ++bj)
#pragma unroll
                    for (int n = 0; n < 2; ++n) { f32x4 x = *(const f32x4*)(in + off + bj * HALF + n * 16);
                        if (st) x = (x - mean) * rstd * gv[bj][n] + bv[bj][n];
                        *(f32x4*)(out + off + bj * HALF + n * 16) = x * alpha + acc[ai][bj][m][n]; } }
    }
};
}

typedef unsigned short bf16_t;
typedef short bf16x8 __attribute__((ext_vector_type(8)));
typedef float f32x4 __attribute__((ext_vector_type(4)));
typedef unsigned u32x4 __attribute__((ext_vector_type(4)));
typedef unsigned u32x2 __attribute__((ext_vector_type(2)));
#define LAS __attribute__((address_space(3)))
constexpr int DM = 1024, NB = 8, TS = 4096, MT = NB * TS, FF = 2816, EW = 2048;
constexpr float LN_EPS = 1e-5f, LNX_EPS = 64e-5f, ALPHA = 1.6817928305074290f;
constexpr int NWAVES = 8, NTHREADS = 512, LDS_BYTES = 147456;
constexpr size_t MiB = 1u << 20, M1 = 1u << 20;
constexpr size_t WS_W = 0, WS_VF = 120 * MiB, WS_XB = 184 * MiB, WS_BIG = 248 * MiB, WS_RK = 504 * MiB, WS_CTL = 508 * MiB, WS_ST = 509 * MiB, WS_END = 510 * MiB;
constexpr size_t WA_SZ = 4 * M1 + 2 * 327680, WA_RKV = 0, WA_OUT = 3 * M1, WA_L1T = 4 * M1, WA_L2W = WA_L1T + 327680, WA_L2A = WA_L2W + 65536, WA_L2V = WA_L2A + 65536, WA_L2G = WA_L2V + 32768;
constexpr size_t WB_OFF = 2 * WA_SZ, WB_SZ = 6 * M1 + 262144, WB_IN = 0, WB_OUT = 4 * M1, WB_WS = 6 * M1;
constexpr size_t WF_OFF = WB_OFF + 2 * WB_SZ, WF_GU = 0, WF_DN = (size_t)5632 * 1024, WF_SZ = WF_DN + (size_t)1024 * 2816;
static_assert((WF_OFF + 4 * WF_SZ) * 2 <= WS_VF, "weights fit");
constexpr size_t BIG_R = 0, BIG_K = 64 * MiB, BIG_V = 128 * MiB, BIG_LH = 192 * MiB, BIG_U = 0, BIG_VG = 128 * MiB, BIG_H = 0;

__device__ __forceinline__ unsigned pk2(float lo, float hi) { return pg8::cvt_pk_bf16(lo, hi); }
__device__ __forceinline__ float bf_lo(unsigned u) { return __uint_as_float(u << 16); }
__device__ __forceinline__ float bf_hi(unsigned u) { return __uint_as_float(u & 0xffff0000u); }
__device__ __forceinline__ f32x4 unpack4(u32x2 u) { return (f32x4){bf_lo(u.x), bf_hi(u.x), bf_lo(u.y), bf_hi(u.y)}; }
__device__ __forceinline__ u32x2 pack4(f32x4 v) { u32x2 r; r.x = pk2(v[0], v[1]); r.y = pk2(v[2], v[3]); return r; }
__device__ __forceinline__ bf16x8 pack8(f32x4 a, f32x4 b) { u32x4 w; w.x = pk2(a[0], a[1]); w.y = pk2(a[2], a[3]); w.z = pk2(b[0], b[1]); w.w = pk2(b[2], b[3]); return __builtin_bit_cast(bf16x8, w); }
__device__ __forceinline__ float wave_sum(float v) {
#pragma unroll
    for (int o = 1; o < 64; o <<= 1) v += __shfl_xor(v, o);
    return v;
}
using pg8::sigmoidf_;
__device__ __forceinline__ float tanhf_(float x) { return 1.0f - 2.0f * pg8::fast_rcp(1.0f + __expf(2.0f * x)); }
#define MFMA16(a, b, c) __builtin_amdgcn_mfma_f32_16x16x32_bf16((a), (b), (c), 0, 0, 0)

__device__ __forceinline__ void transpose_item(const float* W, int K, int N, bf16_t* WT, int mode, LAS float* scr, int item, int lane) {
    const int nblk = N / 32, kb = item / nblk, nb = item % nblk, k0 = 64 * kb, n0 = 32 * nb;
    int d0 = n0;
    if (mode == 1) { d0 = (n0 < FF) ? (256 * (n0 / 128) + (n0 % 128)) : (256 * ((n0 - FF) / 128) + 128 + ((n0 - FF) % 128)); }
#pragma unroll 8
    for (int i = 0; i < 32; ++i) { const int kk = 2 * i + (lane >> 5); scr[kk * 33 + (lane & 31)] = W[(size_t)(k0 + kk) * N + n0 + (lane & 31)]; }
    asm volatile("s_waitcnt lgkmcnt(0)" ::: "memory");
    const int c = lane & 7;
#pragma unroll
    for (int j = 0; j < 4; ++j) { const int n = (lane >> 3) + 8 * j; const LAS float* s = scr + (8 * c) * 33 + n;
        u32x4 o; o.x = pk2(s[0 * 33], s[1 * 33]); o.y = pk2(s[2 * 33], s[3 * 33]); o.z = pk2(s[4 * 33], s[5 * 33]); o.w = pk2(s[6 * 33], s[7 * 33]);
        *(u32x4*)(WT + (size_t)(d0 + n) * K + k0 + 8 * c) = o; }
    asm volatile("s_waitcnt lgkmcnt(0)" ::: "memory");
}
__device__ __forceinline__ void conv_big(const float* W, int K, int N, bf16_t* WT, int mode, LAS float* scr, int gw, int NGW, int& rot, int lane) {
    const int nitems = (K / 64) * (N / 32);
    int start = gw - (rot % NGW); if (start < 0) start += NGW;
    for (int it = start; it < nitems; it += NGW) transpose_item(W, K, N, WT, mode, scr, it, lane);
    rot += nitems;
}
struct In { const float* p[31]; };
__device__ __forceinline__ void phase_convert(const In& in, bf16_t* Wb, LAS unsigned char* lds) {
    int tid_ = threadIdx.x; asm volatile("" : "+v"(tid_)); const int tid = tid_, lane = tid & 63, wave = tid >> 6, gw = blockIdx.x * NWAVES + wave, NGW = gridDim.x * NWAVES;
    LAS float* scr = (LAS float*)(lds + wave * 16384);
    int rot = 0;
    for (int j = 0; j < 2; ++j) {
        for (int c = 0; c < 3; ++c) conv_big(in.p[2] + (size_t)(j * 3 + c) * M1, 1024, 1024, Wb + j * WA_SZ + WA_RKV + c * M1, 0, scr, gw, NGW, rot, lane);
        conv_big(in.p[19] + (size_t)j * M1, 1024, 1024, Wb + j * WA_SZ + WA_OUT, 0, scr, gw, NGW, rot, lane);
        conv_big(in.p[20] + (size_t)j * 4 * M1, 1024, 4096, Wb + WB_OFF + j * WB_SZ + WB_IN, 0, scr, gw, NGW, rot, lane);
        conv_big(in.p[26] + (size_t)j * 2 * M1, 2048, 1024, Wb + WB_OFF + j * WB_SZ + WB_OUT, 0, scr, gw, NGW, rot, lane);
    }
    for (int i = 0; i < 4; ++i) {
        conv_big(in.p[27] + (size_t)i * 1024 * 5632, 1024, 5632, Wb + WF_OFF + i * WF_SZ + WF_GU, 1, scr, gw, NGW, rot, lane);
        conv_big(in.p[28] + (size_t)i * 2816 * 1024, 2816, 1024, Wb + WF_OFF + i * WF_SZ + WF_DN, 0, scr, gw, NGW, rot, lane);
    }
    const int gt = blockIdx.x * NTHREADS + tid, NGT = gridDim.x * NTHREADS;
    for (int j = 0; j < 2; ++j) {
        bf16_t* L1T = Wb + j * WA_SZ + WA_L1T;
        for (int e = gt; e < 320 * 1024; e += NGT) { const int n = e >> 10, k = e & 1023; float v;
            if (n < 64) v = in.p[4][((size_t)j * 1024 + k) * 64 + n];
            else if (n < 128) v = in.p[7][((size_t)j * 1024 + k) * 64 + (n - 64)];
            else if (n < 160) v = (j > 0) ? in.p[10][((size_t)(j - 1) * 1024 + k) * 32 + (n - 128)] : 0.f;
            else v = in.p[12][((size_t)j * 1024 + k) * 160 + (n - 160)];
            L1T[(size_t)(k >> 5) * 10240 + n * 32 + (k & 31)] = (bf16_t)(pk2(v, 0.f) & 0xffffu); }
        bf16_t* L2W = Wb + j * WA_SZ + WA_L2W; bf16_t* L2A = Wb + j * WA_SZ + WA_L2A; bf16_t* L2V = Wb + j * WA_SZ + WA_L2V; bf16_t* L2G = Wb + j * WA_SZ + WA_L2G;
        for (int e = gt; e < 1024 * 64; e += NGT) { const int ch = e >> 6, k = e & 63;
            L2W[e] = (bf16_t)(pk2(in.p[5][((size_t)j * 64 + k) * 1024 + ch], 0.f) & 0xffffu);
            L2A[e] = (bf16_t)(pk2(in.p[8][((size_t)j * 64 + k) * 1024 + ch], 0.f) & 0xffffu); }
        for (int e = gt; e < 1024 * 32; e += NGT) { const int ch = e >> 5, k = e & 31;
            L2V[e] = (bf16_t)(pk2((j > 0) ? in.p[11][((size_t)(j - 1) * 32 + k) * 1024 + ch] : 0.f, 0.f) & 0xffffu); }
        for (int e = gt; e < 1024 * 160; e += NGT) { const int ch = e / 160, k = e % 160;
            L2G[e] = (bf16_t)(pk2(in.p[13][((size_t)j * 160 + k) * 1024 + ch], 0.f) & 0xffffu); }
        bf16_t* WSM = Wb + WB_OFF + j * WB_SZ + WB_WS;
        for (int e = gt; e < 16 * 128 * 128; e += NGT) { const int i = (e >> 7) & 127, jj = e & 127;
            WSM[e] = (bf16_t)(pk2((jj <= i) ? in.p[24][(size_t)j * 262144 + e] : 0.f, 0.f) & 0xffffu); }
    }
}

constexpr int P0_ROWB = 80, P0_SLAB = 320 * P0_ROWB;
__device__ __forceinline__ void phase_prep0(LAS unsigned char* lds, const float* xin, const float* mu, const bf16_t* L1S, bf16_t* XR, bf16_t* XK, bf16_t* XV, bf16_t* LH, bool has_v) {
    int tid_ = threadIdx.x; asm volatile("" : "+v"(tid_)); const int tid = tid_, lane = tid & 63, wave = tid >> 6, fr = lane & 15, fq = lane >> 4;
    LAS float* mus = (LAS float*)lds;
    LAS unsigned char* wb = lds + 24576;
    for (int e = tid; e < 6 * DM / 4; e += NTHREADS) *(LAS f32x4*)(mus + 4 * e) = *(const f32x4*)(mu + 4 * e);
    for (int blk = ((gridDim.x == 256) ? (int)((blockIdx.x & 7) * 32 + (blockIdx.x >> 3)) : (int)blockIdx.x); blk < MT / 128; blk += gridDim.x) {
        const int tok = blk * 128 + wave * 16 + fr; const bool first = (tok % TS) == 0;
        const float* xrow = xin + (size_t)tok * DM; const float* prow = xrow - DM;
        u32x4 wreg[3];
#pragma unroll
        for (int i = 0; i < 3; ++i) { const int q = tid + 512 * i; if (q < 1280) wreg[i] = *(const u32x4*)(L1S + (size_t)q * 8); }
#pragma unroll
        for (int i = 0; i < 3; ++i) { const int q = tid + 512 * i; if (q < 1280) *(LAS u32x4*)(wb + (q >> 2) * P0_ROWB + (q & 3) * 16) = wreg[i]; }
        __syncthreads();
        f32x4 acc[20];
#pragma unroll
        for (int j = 0; j < 20; ++j) acc[j] = (f32x4){0.f, 0.f, 0.f, 0.f};
        f32x4 nx0 = *(const f32x4*)(xrow + 8 * fq), nx1 = *(const f32x4*)(xrow + 8 * fq + 4), np0 = (f32x4){0.f, 0.f, 0.f, 0.f}, np1 = np0;
        if (!first) { np0 = *(const f32x4*)(prow + 8 * fq); np1 = *(const f32x4*)(prow + 8 * fq + 4); }
#pragma unroll 1
        for (int s = 0; s < 32; ++s) {
            const int c0 = 32 * s + 8 * fq;
            if (s + 1 < 32) {
#pragma unroll
                for (int i = 0; i < 3; ++i) { const int q = tid + 512 * i; if (q < 1280) wreg[i] = *(const u32x4*)(L1S + (size_t)(s + 1) * 10240 + (size_t)q * 8); } }
            const f32x4 x0 = nx0, x1 = nx1; f32x4 d0 = np0 - x0, d1 = np1 - x1;
            if (s + 1 < 32) { nx0 = *(const f32x4*)(xrow + c0 + 32); nx1 = *(const f32x4*)(xrow + c0 + 36);
                if (!first) { np0 = *(const f32x4*)(prow + c0 + 32); np1 = *(const f32x4*)(prow + c0 + 36); } }
#define MUV(i, o) (*(const LAS f32x4*)(mus + (i) * DM + c0 + (o)))
            *(bf16x8*)(XR + (size_t)tok * DM + c0) = pack8(x0 + d0 * MUV(0, 0), x1 + d1 * MUV(0, 4));
            *(bf16x8*)(XK + (size_t)tok * DM + c0) = pack8(x0 + d0 * MUV(2, 0), x1 + d1 * MUV(2, 4));
            const bf16x8 xw = pack8(x0 + d0 * MUV(1, 0), x1 + d1 * MUV(1, 4));
            const bf16x8 xv = pack8(x0 + d0 * MUV(3, 0), x1 + d1 * MUV(3, 4));
            if (XV) *(bf16x8*)(XV + (size_t)tok * DM + c0) = xv;
            const bf16x8 xa = pack8(x0 + d0 * MUV(4, 0), x1 + d1 * MUV(4, 4));
            const bf16x8 xg = pack8(x0 + d0 * MUV(5, 0), x1 + d1 * MUV(5, 4));
#undef MUV
            const LAS unsigned char* wsl = wb + (s & 1) * P0_SLAB + fr * P0_ROWB + fq * 16;
#pragma unroll
            for (int j = 0; j < 20; ++j) {
                if (has_v || (j != 8 && j != 9)) {
                    const bf16x8 wf = *(const LAS bf16x8*)(wsl + 16 * j * P0_ROWB);
                    acc[j] = MFMA16(wf, (j < 4) ? xw : (j < 8) ? xa : (j < 10) ? xv : xg, acc[j]);
                }
            }
            if (s + 1 < 32) {
#pragma unroll
                for (int i = 0; i < 3; ++i) { const int q = tid + 512 * i; if (q < 1280) *(LAS u32x4*)(wb + ((s + 1) & 1) * P0_SLAB + (q >> 2) * P0_ROWB + (q & 3) * 16) = wreg[i]; } }
            __syncthreads();
        }
#pragma unroll
        for (int j = 0; j < 20; ++j) { f32x4 v = acc[j];
            if (j < 4) { v[0] = tanhf_(v[0]); v[1] = tanhf_(v[1]); v[2] = tanhf_(v[2]); v[3] = tanhf_(v[3]); }
            if (j >= 10) { v[0] = sigmoidf_(v[0]); v[1] = sigmoidf_(v[1]); v[2] = sigmoidf_(v[2]); v[3] = sigmoidf_(v[3]); }
            *(u32x2*)(LH + (size_t)tok * 320 + 16 * j + 4 * fq) = pack4(v); }
    }
}
__device__ __forceinline__ void phase_shift(const float* xin, const float* mu, bf16_t* dst) {
    int tid_ = threadIdx.x; asm volatile("" : "+v"(tid_)); const int gt = blockIdx.x * NTHREADS + tid_, NGT = gridDim.x * NTHREADS;
    for (int i = gt; i < MT * 128; i += NGT) { const int tok = i >> 7, c0 = (i & 127) * 8;
        const float* xrow = xin + (size_t)tok * DM + c0;
        const f32x4 x0 = *(const f32x4*)xrow, x1 = *(const f32x4*)(xrow + 4);
        f32x4 d0 = (f32x4){0.f, 0.f, 0.f, 0.f}, d1 = d0;
        if ((tok % TS) != 0) { d0 = *(const f32x4*)(xrow - DM); d1 = *(const f32x4*)(xrow - DM + 4); }
        d0 = d0 - x0; d1 = d1 - x1;
        *(bf16x8*)(dst + (size_t)tok * DM + c0) = pack8(x0 + d0 * *(const f32x4*)(mu + c0), x1 + d1 * *(const f32x4*)(mu + c0 + 4)); }
}

__device__ __forceinline__ void phase_ln(const float* pre, const float* g, const float* b, float* xf, bf16_t* xb, float* stats) {
    int tid_ = threadIdx.x; asm volatile("" : "+v"(tid_)); const int tid = tid_, lane = tid & 63, wave = tid >> 6, gw = blockIdx.x * NWAVES + wave, NGW = gridDim.x * NWAVES;
    f32x4 gv[4], bv[4];
#pragma unroll
    for (int j = 0; j < 4; ++j) { gv[j] = *(const f32x4*)(g + 4 * lane + 256 * j); bv[j] = *(const f32x4*)(b + 4 * lane + 256 * j); }
    f32x4 nv[4];
    if (gw < MT) {
#pragma unroll
        for (int j = 0; j < 4; ++j) nv[j] = *(const f32x4*)(pre + (size_t)gw * DM + 4 * lane + 256 * j); }
    for (int row = gw; row < MT; row += NGW) {
        f32x4 v[4]; float s = 0.f;
#pragma unroll
        for (int j = 0; j < 4; ++j) { v[j] = nv[j]; s += (v[j][0] + v[j][1]) + (v[j][2] + v[j][3]); }
        if (row + NGW < MT) {
#pragma unroll
            for (int j = 0; j < 4; ++j) nv[j] = *(const f32x4*)(pre + (size_t)(row + NGW) * DM + 4 * lane + 256 * j); }
        const float mean = wave_sum(s) * (1.f / DM); float s2 = 0.f;
#pragma unroll
        for (int j = 0; j < 4; ++j) { v[j] = v[j] - mean; s2 += (v[j][0] * v[j][0] + v[j][1] * v[j][1]) + (v[j][2] * v[j][2] + v[j][3] * v[j][3]); }
        const float rstd = __builtin_amdgcn_rsqf(wave_sum(s2) * (1.f / DM) + LN_EPS);
        if (stats && lane == 0) { stats[2 * row] = mean; stats[2 * row + 1] = rstd; }
#pragma unroll
        for (int j = 0; j < 4; ++j) { const f32x4 o = v[j] * rstd * gv[j] + bv[j];
            if (xf) *(f32x4*)(xf + (size_t)row * DM + 4 * lane + 256 * j) = o;
            if (xb) *(u32x2*)(xb + (size_t)row * DM + 4 * lane + 256 * j) = pack4(o); }
    }
}

constexpr int SC_TC = 32, SC_STEP = 356, SC_BUF = SC_TC * SC_STEP;
struct ScanP { const bf16_t* R; const bf16_t* K; bf16_t* V; const bf16_t* VF; const bf16_t* LH; const bf16_t* L2W; const bf16_t* L2A; const bf16_t* L2V;
               const float* w0; const float* a0; const float* v0; const float* k_k; const float* k_a; const float* r_k; bf16_t* Y; float* RK; };
__device__ __forceinline__ float red8(float x) {
    x += __int_as_float(__builtin_amdgcn_update_dpp(0, __float_as_int(x), 0xB1, 0xf, 0xf, true));
    x += __int_as_float(__builtin_amdgcn_update_dpp(0, __float_as_int(x), 0x4E, 0xf, 0xf, true));
    x += __int_as_float(__builtin_amdgcn_update_dpp(0, __float_as_int(x), 0x141, 0xf, 0xf, true));
    return x;
}
__device__ __forceinline__ void scan_produce(const ScanP& P, LAS float* buf, int tok, int srow, int h, int half, int cp, int fr, int fq, bool has_v) {
    const bf16_t* lh = P.LH + (size_t)tok * 320 + 8 * fq;
    const bf16x8 xw0 = *(const bf16x8*)(lh), xw1 = *(const bf16x8*)(lh + 32), xa0 = *(const bf16x8*)(lh + 64), xa1 = *(const bf16x8*)(lh + 96);
    float ss = 0.f, rk = 0.f; f32x4 kkq[2], bqq[2];
    const f32x4 z4 = (f32x4){0.f, 0.f, 0.f, 0.f};
    const bool own = cp == half;
    LAS float* p = buf + srow * SC_STEP + 4 * fq;
#pragma unroll
    for (int cc = 0; cc < 2; ++cc) {
        const int ct = 2 * cp + cc;
        const int crow = 64 * h + 16 * ct + fr, c = 64 * h + 16 * ct + 4 * fq;
        f32x4 aw = MFMA16(*(const bf16x8*)(P.L2W + (size_t)crow * 64 + 8 * fq), xw0, z4); aw = MFMA16(*(const bf16x8*)(P.L2W + (size_t)crow * 64 + 32 + 8 * fq), xw1, aw);
        f32x4 aa = MFMA16(*(const bf16x8*)(P.L2A + (size_t)crow * 64 + 8 * fq), xa0, z4); aa = MFMA16(*(const bf16x8*)(P.L2A + (size_t)crow * 64 + 32 + 8 * fq), xa1, aa);
        const f32x4 w0v = *(const f32x4*)(P.w0 + c), a0v = *(const f32x4*)(P.a0 + c), kkw = *(const f32x4*)(P.k_k + c), kaw = *(const f32x4*)(P.k_a + c), rkw = *(const f32x4*)(P.r_k + c);
        const f32x4 r4 = unpack4(*(const u32x2*)(P.R + (size_t)tok * DM + c)), k4 = unpack4(*(const u32x2*)(P.K + (size_t)tok * DM + c));
        if (own) {
            f32x4 v4 = unpack4(*(const u32x2*)(P.V + (size_t)tok * DM + c));
            if (has_v) {
                const bf16x8 xv0 = *(const bf16x8*)(lh + 128);
                const f32x4 an = MFMA16(*(const bf16x8*)(P.L2V + (size_t)crow * 32 + 8 * fq), xv0, z4);
                const f32x4 vf4 = unpack4(*(const u32x2*)(P.VF + (size_t)tok * DM + c)), v0v = *(const f32x4*)(P.v0 + c);
#pragma unroll
                for (int j = 0; j < 4; ++j) v4[j] = v4[j] + (vf4[j] - v4[j]) * sigmoidf_(v0v[j] + an[j]);
                *(u32x2*)(P.V + (size_t)tok * DM + c) = pack4(v4);
            }
            *(LAS f32x4*)(p + 320 + 16 * cc) = v4;
        }
        f32x4 dec, kkv, bq, kp;
#pragma unroll
        for (int j = 0; j < 4; ++j) {
            dec[j] = __expf(-0.60653065971263342f * sigmoidf_(w0v[j] + aw[j]));
            const float as = sigmoidf_(a0v[j] + aa[j]);
            const float kk = k4[j] * kkw[j]; kkv[j] = kk; bq[j] = kk * as; ss += kk * kk;
            const float kq = k4[j] * (1.0f + (as - 1.0f) * kaw[j]); kp[j] = kq;
            rk += r4[j] * kq * rkw[j];
        }
        *(LAS f32x4*)(p + 16 * ct) = dec;
        kkq[cc] = kkv; bqq[cc] = bq;
        *(LAS f32x4*)(p + 192 + 16 * ct) = kp;
        *(LAS f32x4*)(p + 256 + 16 * ct) = r4;
    }
#pragma unroll
    for (int cc = 0; cc < 2; ++cc) { const int c2 = 64 * h + 16 * (2 * (1 - cp) + cc) + 4 * fq;
        const f32x4 ko = unpack4(*(const u32x2*)(P.K + (size_t)tok * DM + c2)) * *(const f32x4*)(P.k_k + c2);
        ss += (ko[0] * ko[0] + ko[1] * ko[1]) + (ko[2] * ko[2] + ko[3] * ko[3]); }
    ss += __shfl_xor(ss, 16); ss += __shfl_xor(ss, 32);
    rk += __shfl_xor(rk, 16); rk += __shfl_xor(rk, 32);
    const float inv = 1.0f / fmaxf(sqrtf(ss), 1e-12f);
#pragma unroll
    for (int cc = 0; cc < 2; ++cc) { const int ct = 2 * cp + cc;
        *(LAS f32x4*)(p + 64 + 16 * ct) = kkq[cc] * (-inv);
        *(LAS f32x4*)(p + 128 + 16 * ct) = bqq[cc] * inv; }
    if (fq == 0) { if (half == 0) P.RK[((size_t)((tok / TS) * 16 + h) * 2 + cp) * TS + (tok % TS)] = rk; }
}
typedef float f32x2 __attribute__((ext_vector_type(2)));
struct ScanOps { f32x4 w0, w1, a0, a1, b0, b1, k0, k1, r0, r1; float v; };
__device__ __forceinline__ void scan_load(ScanOps& o, const LAS float* p, const LAS float* pv, const LAS float* pn) {
    o.w0 = *(const LAS f32x4*)(p); o.w1 = *(const LAS f32x4*)(p + 4); o.a0 = *(const LAS f32x4*)(p + 64); o.a1 = *(const LAS f32x4*)(p + 68);
    o.b0 = *(const LAS f32x4*)(p + 128); o.b1 = *(const LAS f32x4*)(p + 132); o.k0 = *(const LAS f32x4*)(p + 192); o.k1 = *(const LAS f32x4*)(p + 196);
    o.r0 = *(const LAS f32x4*)(p + 256); o.r1 = *(const LAS f32x4*)(p + 260);
    o.v = *pv; (void)pn;
}
#define LO2(v) ((f32x2){(v)[0], (v)[1]})
#define HI2(v) ((f32x2){(v)[2], (v)[3]})
__device__ __forceinline__ float scan_step(f32x2 (&S)[4], const ScanOps& o) {
    f32x2 t = S[0] * LO2(o.a0); t = S[1] * HI2(o.a0) + t; t = S[2] * LO2(o.a1) + t; t = S[3] * HI2(o.a1) + t;
    const float sa = red8(t[0] + t[1]);
    const f32x2 sa2 = (f32x2){sa, sa}, v2 = (f32x2){o.v, o.v};
    S[0] = S[0] * LO2(o.w0) + (sa2 * LO2(o.b0) + v2 * LO2(o.k0));
    S[1] = S[1] * HI2(o.w0) + (sa2 * HI2(o.b0) + v2 * HI2(o.k0));
    S[2] = S[2] * LO2(o.w1) + (sa2 * LO2(o.b1) + v2 * LO2(o.k1));
    S[3] = S[3] * HI2(o.w1) + (sa2 * HI2(o.b1) + v2 * HI2(o.k1));
    f32x2 y = S[0] * LO2(o.r0); y = S[1] * HI2(o.r0) + y; y = S[2] * LO2(o.r1) + y; y = S[3] * HI2(o.r1) + y;
    return red8(y[0] + y[1]);
}
__device__ __forceinline__ void phase_scan(const ScanP& P, LAS unsigned char* lds, bool has_v) {
    int tid_ = threadIdx.x; asm volatile("" : "+v"(tid_)); const int tid = tid_, lane = tid & 63, wave = __builtin_amdgcn_readfirstlane(tid >> 6), fr = lane & 15, fq = lane >> 4;
    LAS float* ring = (LAS float*)lds; LAS float* ybuf = ring + 2 * SC_BUF;
    const int row = (tid >> 3) & 31, cgi = tid & 7, cg8 = cgi * 8;
    const int pw = (wave - 4) & 3, ptt = pw & 1, pcp = pw >> 1, psr = 16 * ptt + fr;
    for (int unit = (gridDim.x == 256) ? (int)((blockIdx.x & 7) * 32 + (blockIdx.x >> 3)) : (int)blockIdx.x; unit < 256; unit += gridDim.x) {
        const int pair = unit >> 1, half = unit & 1, b = pair >> 4, h = pair & 15, m0 = b * TS;
        if (wave >= 4) scan_produce(P, ring, m0 + psr, psr, h, half, pcp, fr, fq, has_v);
        __syncthreads();
        f32x2 S2[4];
#pragma unroll
        for (int j = 0; j < 4; ++j) S2[j] = (f32x2){0.f, 0.f};
        float yk = 0.f;
        for (int c = 0; c < TS / SC_TC; ++c) {
            LAS float* buf = ring + (c & 1) * SC_BUF;
            if (wave < 4) {
                LAS float* yb = ybuf + (c & 1) * 1024;
                const LAS float* pb = buf + cg8;
                const LAS float* pv = buf + 320 + row;
                const LAS float* pn = buf + 352;
                ScanOps A, B;
                scan_load(A, pb, pv, pn);
#pragma unroll 1
                for (int s = 0; s < SC_TC; s += 8) {
#pragma unroll
                    for (int u = 0; u < 8; u += 2) {
                        scan_load(B, pb + (s + u + 1) * SC_STEP, pv + (s + u + 1) * SC_STEP, pn + (s + u + 1) * SC_STEP);
                        { const float y = scan_step(S2, A); yk = (cgi == u) ? y : yk; }
                        scan_load(A, pb + ((s + u + 2) & (SC_TC - 1)) * SC_STEP, pv + ((s + u + 2) & (SC_TC - 1)) * SC_STEP, pn + ((s + u + 2) & (SC_TC - 1)) * SC_STEP);
                        { const float y = scan_step(S2, B); yk = (cgi == u + 1) ? y : yk; }
                    }
                    yb[(s + cgi) * 32 + row] = yk;
                }
            } else if (c + 1 < TS / SC_TC) {
                scan_produce(P, ring + ((c + 1) & 1) * SC_BUF, m0 + (c + 1) * SC_TC + psr, psr, h, half, pcp, fr, fq, has_v);
            }
            __syncthreads();
            if (wave < 4) {
                const int step = tid >> 3, r4 = (tid & 7) * 4;
                const f32x4 yv = *(const LAS f32x4*)(ybuf + (c & 1) * 1024 + step * 32 + r4);
                *(u32x2*)(P.Y + (size_t)(m0 + c * SC_TC + step) * DM + 64 * h + 32 * half + r4) = pack4(yv);
            }
        }
        __syncthreads();
    }
}
constexpr int PO_ROWB = 336, PO_TILE = 64 * PO_ROWB;
__device__ __forceinline__ void phase_post(LAS unsigned char* lds, bf16_t* Y, const bf16_t* V, const float* RK, const bf16_t* LH, const bf16_t* L2G, const float* lnx_g, const float* lnx_b) {
    int tid_ = threadIdx.x; asm volatile("" : "+v"(tid_)); const int tid = tid_, lane = tid & 63, wave = tid >> 6, fr = lane & 15, fq = lane >> 4;
    for (int blk = ((gridDim.x == 256) ? (int)((blockIdx.x & 7) * 32 + (blockIdx.x >> 3)) : (int)blockIdx.x); blk < MT / 128; blk += gridDim.x) {
        const int tok = blk * 128 + wave * 16 + fr;
        bf16x8 xg[5];
#pragma unroll
        for (int kk = 0; kk < 5; ++kk) xg[kk] = *(const bf16x8*)(LH + (size_t)tok * 320 + 160 + 32 * kk + 8 * fq);
        u32x4 wreg[3];
#pragma unroll
        for (int i = 0; i < 3; ++i) { const int q = tid + 512 * i; if (q < 1280) wreg[i] = *(const u32x4*)(L2G + (size_t)q * 8); }
#pragma unroll
        for (int i = 0; i < 3; ++i) { const int q = tid + 512 * i; if (q < 1280) *(LAS u32x4*)(lds + (q / 20) * PO_ROWB + (q % 20) * 16) = wreg[i]; }
        __syncthreads();
#pragma unroll 1
        for (int h = 0; h < 16; ++h) {
            if (h + 1 < 16) {
#pragma unroll
                for (int i = 0; i < 3; ++i) { const int q = tid + 512 * i; if (q < 1280) wreg[i] = *(const u32x4*)(L2G + (size_t)(h + 1) * 10240 + (size_t)q * 8); } }
            const size_t rki = ((size_t)((tok / TS) * 16 + h) * 2) * TS + (tok % TS); const float rk = RK[rki] + RK[rki + TS];
            const LAS unsigned char* wt = lds + (h & 1) * PO_TILE + fq * 16;
            f32x4 yv[4], g[4]; float s = 0.f;
#pragma unroll
            for (int p = 0; p < 2; ++p) {
                const int c8 = 64 * h + 32 * p + 8 * fq;
#pragma unroll
                for (int t = 0; t < 2; ++t) {
                    const int lrow = 32 * p + 8 * (fr >> 2) + 4 * t + (fr & 3);
                    f32x4 acc = (f32x4){0.f, 0.f, 0.f, 0.f};
#pragma unroll
                    for (int kk = 0; kk < 5; ++kk) acc = MFMA16(*(const LAS bf16x8*)(wt + lrow * PO_ROWB + 64 * kk), xg[kk], acc);
                    g[2 * p + t] = acc; }
                const u32x4 yr = *(const u32x4*)(Y + (size_t)tok * DM + c8);
                yv[2 * p] = unpack4((u32x2){yr.x, yr.y}); yv[2 * p + 1] = unpack4((u32x2){yr.z, yr.w});
                s += (yv[2 * p][0] + yv[2 * p][1]) + (yv[2 * p][2] + yv[2 * p][3]) + (yv[2 * p + 1][0] + yv[2 * p + 1][1]) + (yv[2 * p + 1][2] + yv[2 * p + 1][3]);
            }
            s += __shfl_xor(s, 16); s += __shfl_xor(s, 32);
            const float mean = s * (1.f / 64.f); float q = 0.f;
#pragma unroll
            for (int ct = 0; ct < 4; ++ct) { yv[ct] = yv[ct] - mean; q += (yv[ct][0] * yv[ct][0] + yv[ct][1] * yv[ct][1]) + (yv[ct][2] * yv[ct][2] + yv[ct][3] * yv[ct][3]); }
            q += __shfl_xor(q, 16); q += __shfl_xor(q, 32);
            const float rstd = __builtin_amdgcn_rsqf(q * (1.f / 64.f) + LNX_EPS);
#pragma unroll
            for (int p = 0; p < 2; ++p) {
                const int c8 = 64 * h + 32 * p + 8 * fq;
                const u32x4 vr = *(const u32x4*)(V + (size_t)tok * DM + c8);
                const f32x4 o0 = (yv[2 * p] * rstd * *(const f32x4*)(lnx_g + c8) + *(const f32x4*)(lnx_b + c8) + unpack4((u32x2){vr.x, vr.y}) * rk) * g[2 * p];
                const f32x4 o1 = (yv[2 * p + 1] * rstd * *(const f32x4*)(lnx_g + c8 + 4) + *(const f32x4*)(lnx_b + c8 + 4) + unpack4((u32x2){vr.z, vr.w}) * rk) * g[2 * p + 1];
                u32x4 o; o.x = pk2(o0[0], o0[1]); o.y = pk2(o0[2], o0[3]); o.z = pk2(o1[0], o1[1]); o.w = pk2(o1[2], o1[3]);
                *(u32x4*)(Y + (size_t)tok * DM + c8) = o;
            }
            if (h + 1 < 16) {
#pragma unroll
                for (int i = 0; i < 3; ++i) { const int q = tid + 512 * i; if (q < 1280) *(LAS u32x4*)(lds + ((h + 1) & 1) * PO_TILE + (q / 20) * PO_ROWB + (q % 20) * 16) = wreg[i]; } }
            __syncthreads();
        }
    }
}
constexpr int SG_WRS = 272, SG_WT = 128 * SG_WRS;
constexpr int SG_RS = 260, SG_VN = 128 * SG_RS;
__device__ __forceinline__ void sgu_stage(LAS unsigned char* vn, const LAS float* st, const u32x4 (&raw)[4], const float* ln_g, const float* ln_b, int g, int tid) {
#pragma unroll
    for (int q = 0; q < 4; ++q) { const int idx = tid + 512 * q, tok = idx >> 4, ch8 = (idx & 15) * 8;
        const float mean = st[2 * tok], rstd = st[2 * tok + 1];
        const f32x4 g0 = *(const f32x4*)(ln_g + 128 * g + ch8), g1 = *(const f32x4*)(ln_g + 128 * g + ch8 + 4), b0 = *(const f32x4*)(ln_b + 128 * g + ch8), b1 = *(const f32x4*)(ln_b + 128 * g + ch8 + 4);
        const f32x4 n0 = (unpack4((u32x2){raw[q].x, raw[q].y}) - mean) * rstd * g0 + b0, n1 = (unpack4((u32x2){raw[q].z, raw[q].w}) - mean) * rstd * g1 + b1;
        LAS unsigned* d = (LAS unsigned*)(vn + tok * SG_RS + ch8 * 2);
        d[0] = pk2(n0[0], n0[1]); d[1] = pk2(n0[2], n0[3]); d[2] = pk2(n1[0], n1[1]); d[3] = pk2(n1[2], n1[3]); }
}
__device__ __forceinline__ void phase_sgu(LAS unsigned char* lds, bf16_t* U, const bf16_t* VG, const float* ln_g, const float* ln_b, const bf16_t* WSM, const float* b_s) {
    int tid_ = threadIdx.x; asm volatile("" : "+v"(tid_)); const int tid = tid_, lane = tid & 63, wave = __builtin_amdgcn_readfirstlane(tid >> 6), fr = lane & 15, fq = lane >> 4;
    LAS float* st = (LAS float*)lds; LAS unsigned char* vn0 = lds + 1024; LAS unsigned char* ws0 = vn0 + 2 * SG_VN;
    for (int unit = ((gridDim.x == 256) ? (int)((blockIdx.x & 7) * 32 + (blockIdx.x >> 3)) : (int)blockIdx.x); unit < MT / 128; unit += gridDim.x) {
        const size_t m0 = (size_t)unit * 128;
#pragma unroll 1
        for (int tk = 0; tk < 16; tk += 4) {
            float s1[4], s2[4];
#pragma unroll
            for (int r = 0; r < 4; ++r) { const bf16_t* rowp = VG + (m0 + 16 * wave + tk + r) * EW + 8 * lane; s1[r] = 0.f; s2[r] = 0.f;
#pragma unroll
                for (int q = 0; q < 4; ++q) { const u32x4 raw = *(const u32x4*)(rowp + 512 * q); const f32x4 a = unpack4((u32x2){raw.x, raw.y}), b = unpack4((u32x2){raw.z, raw.w});
                    s1[r] += (a[0] + a[1]) + (a[2] + a[3]) + (b[0] + b[1]) + (b[2] + b[3]);
                    s2[r] += (a[0] * a[0] + a[1] * a[1]) + (a[2] * a[2] + a[3] * a[3]) + (b[0] * b[0] + b[1] * b[1]) + (b[2] * b[2] + b[3] * b[3]); } }
#pragma unroll
            for (int o = 1; o < 64; o <<= 1) {
#pragma unroll
                for (int r = 0; r < 4; ++r) { s1[r] += __shfl_xor(s1[r], o); s2[r] += __shfl_xor(s2[r], o); } }
            if (lane == 0) {
#pragma unroll
                for (int r = 0; r < 4; ++r) { const float m = s1[r] * (1.f / EW); const float var = fmaxf(s2[r] * (1.f / EW) - m * m, 0.f);
                    st[2 * (16 * wave + tk + r)] = m; st[2 * (16 * wave + tk + r) + 1] = __builtin_amdgcn_rsqf(var + LN_EPS); } }
        }
        u32x4 raw[4];
#pragma unroll
        for (int q = 0; q < 4; ++q) { const int idx = tid + 512 * q; raw[q] = *(const u32x4*)(VG + (m0 + (idx >> 4)) * EW + (idx & 15) * 8); }
        u32x4 wsr[4];
#pragma unroll
        for (int q = 0; q < 4; ++q) { const int idx = tid + 512 * q; wsr[q] = *(const u32x4*)(WSM + (size_t)idx * 8); }
        __syncthreads();
        sgu_stage(vn0, st, raw, ln_g, ln_b, 0, tid);
#pragma unroll
        for (int q = 0; q < 4; ++q) { const int idx = tid + 512 * q; *(LAS u32x4*)(ws0 + (idx >> 4) * SG_WRS + (idx & 15) * 16) = wsr[q]; }
        __syncthreads();
#pragma unroll 1
        for (int g = 0; g < 16; ++g) {
            const LAS unsigned char* vn = vn0 + (g & 1) * SG_VN;
            if (g + 1 < 16) {
#pragma unroll
                for (int q = 0; q < 4; ++q) { const int idx = tid + 512 * q; raw[q] = *(const u32x4*)(VG + (m0 + (idx >> 4)) * EW + 128 * (g + 1) + (idx & 15) * 8); wsr[q] = *(const u32x4*)(WSM + (size_t)(g + 1) * 16384 + (size_t)idx * 8); } }
            const LAS unsigned char* wsl = ws0 + (g & 1) * SG_WT + fr * SG_WRS + fq * 16;
            const int cw = wave & 3, th = wave >> 2, c8 = 128 * g + 32 * cw + 8 * fq;
            u32x4 uraw[4]; float bias[4];
#pragma unroll
            for (int q = 0; q < 4; ++q) { const int tokl = 16 * (th + 2 * q) + fr; uraw[q] = *(const u32x4*)(U + (m0 + tokl) * EW + c8); bias[q] = b_s[g * 128 + tokl]; }
            bf16x8 af[2][4];
#pragma unroll
            for (int t = 0; t < 2; ++t)
#pragma unroll
                for (int s = 0; s < 4; ++s)
#pragma unroll
                    for (int e = 0; e < 8; ++e) af[t][s][e] = *(const LAS short*)(vn + (32 * s + 8 * fq + e) * SG_RS + (32 * cw + 8 * (fr >> 2) + 4 * t + (fr & 3)) * 2);
#pragma unroll
            for (int q = 0; q < 4; ++q) {
                const int tokl = 16 * (th + 2 * q) + fr;
                f32x4 acc0 = (f32x4){0.f, 0.f, 0.f, 0.f}, acc1 = acc0;
#pragma unroll
                for (int s = 0; s <= q; ++s) { const bf16x8 wf = *(const LAS bf16x8*)(wsl + 16 * (th + 2 * q) * SG_WRS + 64 * s);
                    acc0 = MFMA16(af[0][s], wf, acc0); acc1 = MFMA16(af[1][s], wf, acc1); }
                const f32x4 u0 = unpack4((u32x2){uraw[q].x, uraw[q].y}) * (acc0 + bias[q]), u1 = unpack4((u32x2){uraw[q].z, uraw[q].w}) * (acc1 + bias[q]);
                u32x4 o; o.x = pk2(u0[0], u0[1]); o.y = pk2(u0[2], u0[3]); o.z = pk2(u1[0], u1[1]); o.w = pk2(u1[2], u1[3]);
                *(u32x4*)(U + (m0 + tokl) * EW + c8) = o;
            }
            if (g + 1 < 16) sgu_stage(vn0 + ((g + 1) & 1) * SG_VN, st, raw, ln_g, ln_b, g + 1, tid);
            if (g + 1 < 16) {
#pragma unroll
                for (int q = 0; q < 4; ++q) { const int idx = tid + 512 * q; *(LAS u32x4*)(ws0 + ((g + 1) & 1) * SG_WT + (idx >> 4) * SG_WRS + (idx & 15) * 16) = wsr[q]; } }
            __syncthreads();
        }
    }
}
#define RLX_AGENT __ATOMIC_RELAXED, __HIP_MEMORY_SCOPE_AGENT
#define XB_TMO      128
#define XB_XCNT(j)  (256  + 64 * (j))
#define XB_XSUB(j)  (1280 + 64 * (j))
#define XB_XGEN(j)  (2304 + 64 * (j))
#define XB_TOP      3328
#define XB_TOPGEN   3392
#define XCD_BAR_WORDS 3456
#define XB_SPIN_CAP (1u << 18)

__device__ __forceinline__ unsigned xb_ld(unsigned* p)              { return __hip_atomic_load(p, __ATOMIC_RELAXED, __HIP_MEMORY_SCOPE_AGENT); }
__device__ __forceinline__ unsigned xb_add(unsigned* p, unsigned v) { return __hip_atomic_fetch_add(p, v, __ATOMIC_RELAXED, __HIP_MEMORY_SCOPE_AGENT); }
__device__ __forceinline__ unsigned xb_xcc_id() { return (unsigned)__builtin_amdgcn_s_getreg((3 << 11) | 20) & 0xFu; }
#define XB_SPIN(cond, bar) do { unsigned _sp = 0; while (cond) { __builtin_amdgcn_s_sleep(1); \
    if ((++_sp & 255u) == 0u) { if (xb_ld(&(bar)[XB_TMO])) break; if (_sp > XB_SPIN_CAP) { atomicAdd(&(bar)[XB_TMO], 1u); break; } } } } while (0)

struct XcdBarrier {
    unsigned* bar; unsigned x;
    volatile LAS unsigned* st;
};

__device__ __forceinline__ XcdBarrier xcd_barrier_post(unsigned* bar, volatile LAS unsigned* st) {
    XcdBarrier b; b.bar = bar; b.x = xb_xcc_id(); b.st = st;
    if (threadIdx.x == 0) (void)xb_add(&bar[XB_XCNT(b.x)], 1u);
    return b;
}
__device__ __forceinline__ void xcd_barrier_complete(unsigned* bar, unsigned x, unsigned& nloc, unsigned& nx) {
    const unsigned G = gridDim.x * gridDim.y * gridDim.z;
    unsigned sum, cnt, mine, sp = 0u;
    for (;;) {
        sum = 0u; cnt = 0u; mine = 0u;
#pragma unroll
        for (unsigned j = 0; j < 16; ++j) { const unsigned c = xb_ld(&bar[XB_XCNT(j)]); sum += c; cnt += (c > 0u) ? 1u : 0u; mine = (j == x) ? c : mine; }
        if (sum == G) break;
        __builtin_amdgcn_s_sleep(1);
        if ((++sp & 255u) == 0u) { if (xb_ld(&bar[XB_TMO])) break; if (sp > XB_SPIN_CAP) { atomicAdd(&bar[XB_TMO], 1u); break; } }
    }
    nloc = mine > 0u ? mine : 1u; nx = cnt > 0u ? cnt : 1u;
}

__device__ __forceinline__ void xcd_barrier(const XcdBarrier& b) {
    asm volatile("s_waitcnt vmcnt(0)" ::: "memory");
    __syncthreads();
    if (threadIdx.x == 0) {
        unsigned* bar = b.bar;
        __builtin_amdgcn_s_waitcnt(0);
        unsigned nloc = b.st[0], nx = b.st[1];
        if (nloc == 0u) { xcd_barrier_complete(bar, b.x, nloc, nx); b.st[0] = nloc; b.st[1] = nx; }
        const unsigned old = xb_add(&bar[XB_XSUB(b.x)], 1u);
        const unsigned gen = old / nloc;
        if (old + 1u == (gen + 1u) * nloc) {
            __builtin_amdgcn_fence(__ATOMIC_RELEASE, "agent");
            asm volatile("s_waitcnt vmcnt(0)" ::: "memory");
            const unsigned og = xb_add(&bar[XB_TOP], 1u);
            const unsigned tg = og / nx;
            if (og + 1u == (tg + 1u) * nx) xb_add(&bar[XB_TOPGEN], 1u);
            else XB_SPIN(xb_ld(&bar[XB_TOPGEN]) == tg, bar);
            __builtin_amdgcn_fence(__ATOMIC_ACQUIRE, "agent");
            xb_add(&bar[XB_XGEN(b.x)], 1u);
            asm volatile("s_waitcnt vmcnt(0)" ::: "memory");
        } else {
            XB_SPIN(xb_ld(&bar[XB_XGEN(b.x)]) == gen, bar);
            __builtin_amdgcn_fence(__ATOMIC_ACQUIRE, "agent");
            asm volatile("s_waitcnt vmcnt(0)" ::: "memory");
        }
    }
    __syncthreads();
}

struct Args { const float* in[31]; float* out; unsigned char* ws; int ph; int pad; };
constexpr int N_PHASES = 35;
#ifndef N_RUN
#define N_RUN 35
#endif
#ifndef PH_MASK
#define PH_MASK 0xffff
#endif
#define PHM(b) ((PH_MASK >> (b)) & 1)


#ifndef MK_MULTI
#define MK_MULTI 0
#endif

template <class Epi>
__device__ __forceinline__ void run_gemm(LAS unsigned char* lds, const bf16_t* A, const bf16_t* Bt, int N, int K, const Epi& E) {
    pg8::Gemm g{A, Bt, MT, N, K}; pg8::StaticOrder S; S.init(MT, N, (int)gridDim.x, (int)blockIdx.x);
    pg8::gemm_phase<Epi, pg8::StaticOrder, true, true>(lds, g, S, E);
}

__global__ void __launch_bounds__(NTHREADS) fwd_megakernel(Args args) {
    extern __shared__ __attribute__((aligned(16))) unsigned char lds_raw[];
    LAS unsigned char* lds = (LAS unsigned char*)lds_raw;
    cg::grid_group grid = cg::this_grid();
    const bool all = args.ph < 0; int cur = 0;
#define RUN (all || (cur++ == args.ph))
#define SEAM() do { if (all) xcd_barrier(xbar); } while (0)
    In in;
#pragma unroll
    for (int i = 0; i < 31; ++i) in.p[i] = args.in[i];
    unsigned char* ws = args.ws;
    bf16_t* Wb = (bf16_t*)(ws + WS_W);
    bf16_t* VF = (bf16_t*)(ws + WS_VF); bf16_t* XB = (bf16_t*)(ws + WS_XB);
    unsigned char* big = ws + WS_BIG;
    float* RK = (float*)(ws + WS_RK);
    float* XF = args.out; float* ST = (float*)(ws + WS_ST);

    unsigned* barw = (unsigned*)(ws + WS_CTL);
    volatile LAS unsigned* bst = (volatile LAS unsigned*)(lds + LDS_BYTES - 64);
    if (threadIdx.x < 2) bst[threadIdx.x] = 0u;
    if (all && blockIdx.x == 0) for (int u = threadIdx.x; u < XCD_BAR_WORDS; u += NTHREADS) barw[u] = 0u;
    if (PHM(0) && RUN) phase_convert(in, Wb, lds);
    XcdBarrier xbar; xbar.bar = barw; xbar.x = 0; xbar.st = bst;
    if (all) { grid.sync(); xbar = xcd_barrier_post(barw, bst); }
    for (int i = 0; i < 4; ++i) {
        const int j = i >> 1;
        const float* xin = (i == 0) ? in.p[0] : XF;
        const bf16_t* WF = Wb + WF_OFF + (size_t)i * WF_SZ;
        const bf16_t* mixA; const bf16_t* mixB; int mixK; const float* mixSt = nullptr;
        if ((i & 1) == 0) {
            const bool has_v = j > 0;
            const bf16_t* WA = Wb + (size_t)j * WA_SZ;
            const float* mu = in.p[1] + (size_t)j * 6 * DM;
            bf16_t* Rb = (bf16_t*)(big + BIG_R); bf16_t* Kb = (bf16_t*)(big + BIG_K); bf16_t* Vb = has_v ? (bf16_t*)(big + BIG_V) : VF; bf16_t* LH = (bf16_t*)(big + BIG_LH);
            bf16_t* XK2 = (bf16_t*)(big + BIG_V);
            bf16_t* XV2 = has_v ? nullptr : (bf16_t*)XF;
            if (PHM(1) && RUN) phase_prep0(lds, xin, mu, WA + WA_L1T, XB, XK2, XV2, LH, has_v);
            SEAM();
            if (PHM(3) && RUN) {
                const int nc = XV2 ? 3 : 2;
                for (int c = 0; c < nc; ++c) { pg8::EpiBf16<0> E{c == 0 ? Rb : (c == 1 ? Kb : Vb), DM, nullptr, 0, 0}; run_gemm(lds, c == 0 ? XB : (c == 1 ? XK2 : XV2), WA + WA_RKV + (size_t)c * M1, DM, DM, E); } }
            SEAM();
            if (!XV2) {
                if (PHM(2) && RUN) phase_shift(xin, mu + 3 * DM, XB);
                SEAM();
                if (PHM(3) && RUN) { pg8::EpiBf16<0> E{Vb, DM, nullptr, 0, 0}; run_gemm(lds, XB, WA + WA_RKV + (size_t)2 * M1, DM, DM, E); }
                SEAM();
            }
            if (PHM(4) && RUN) { ScanP P{Rb, Kb, Vb, VF, LH, WA + WA_L2W, WA + WA_L2A, WA + WA_L2V, in.p[3] + j * DM, in.p[6] + j * DM, in.p[9] + (has_v ? (j - 1) * DM : 0), in.p[14] + j * DM, in.p[15] + j * DM, in.p[16] + j * DM, XB, RK};
                phase_scan(P, lds, has_v);
            }
            SEAM();
                        if (PHM(5) && RUN) phase_post(lds, XB, Vb, RK, LH, WA + WA_L2G, in.p[17] + j * DM, in.p[18] + j * DM);
            SEAM();
            mixA = XB; mixB = WA + WA_OUT; mixK = DM;
        } else {
            const bf16_t* WB = Wb + WB_OFF + (size_t)j * WB_SZ;
            bf16_t* U = (bf16_t*)(big + BIG_U); bf16_t* VG = (bf16_t*)(big + BIG_VG);
            if (PHM(6) && RUN) { pg8::EpiBf16<1> E{U, EW, in.p[21] + (size_t)j * 2 * EW, EW, (size_t)MT * EW}; run_gemm(lds, XB, WB + WB_IN, 2 * EW, DM, E); }
            SEAM();
                        if (PHM(7) && RUN) phase_sgu(lds, U, VG, in.p[22] + j * EW, in.p[23] + j * EW, WB + WB_WS, in.p[25] + j * 2048);
            SEAM();
            mixA = U; mixB = WB + WB_OUT; mixK = EW; mixSt = ST;
        }
        if (PHM(8) && RUN) { pg8::EpiResid E{xin, mixSt, in.p[29] + (size_t)(2 * i - 1) * DM, in.p[30] + (size_t)(2 * i - 1) * DM, XF, DM, ALPHA}; run_gemm(lds, mixA, mixB, DM, mixK, E); }
        SEAM();
        if (PHM(9) && RUN) phase_ln(XF, in.p[29] + (size_t)(2 * i) * DM, in.p[30] + (size_t)(2 * i) * DM, nullptr, XB, ST);
        SEAM();
        bf16_t* H = (bf16_t*)(big + BIG_H);
        if (PHM(10) && RUN) { pg8::EpiSwiglu E{H, FF}; run_gemm(lds, XB, WF + WF_GU, 2 * FF, DM, E);
        }
        SEAM();
        if (PHM(11) && RUN) { pg8::EpiResid E{XF, ST, in.p[29] + (size_t)(2 * i) * DM, in.p[30] + (size_t)(2 * i) * DM, XF, DM, ALPHA};
            run_gemm(lds, H, WF + WF_DN, DM, FF, E); }
        SEAM();
        if (PHM(12) && RUN) phase_ln(XF, in.p[29] + (size_t)(2 * i + 1) * DM, in.p[30] + (size_t)(2 * i + 1) * DM, (i & 1) ? XF : nullptr, (i & 1) ? nullptr : XB, ST);
        if (i < 3) SEAM();
    }
#undef RUN
#undef SEAM
}

extern "C" void kernel_launch(void* const* d_in, const int* in_sizes, int n_in, void* d_out, int out_size, void* d_ws, size_t ws_size, hipStream_t stream) {
    static int grid = 0;
    if (grid == 0) {
        if (n_in != 31 || out_size != MT * DM || ws_size < WS_END) { fprintf(stderr, "kernel_launch: unexpected shapes: n_in %d out %d ws %zu\n", n_in, out_size, ws_size); grid = -1; return; }
        int dev = 0, cus = 0, per_cu = 0;
        hipGetDevice(&dev); hipDeviceGetAttribute(&cus, hipDeviceAttributeMultiprocessorCount, dev);
        if (hipFuncSetAttribute((const void*)fwd_megakernel, hipFuncAttributeMaxDynamicSharedMemorySize, LDS_BYTES) != hipSuccess) { fprintf(stderr, "kernel_launch: hipFuncSetAttribute failed\n"); grid = -1; return; }
        if (hipOccupancyMaxActiveBlocksPerMultiprocessor(&per_cu, (const void*)fwd_megakernel, NTHREADS, LDS_BYTES) != hipSuccess || per_cu < 1) { fprintf(stderr, "kernel_launch: occupancy query gave %d\n", per_cu); per_cu = 1; }
        (void)hipGetLastError();
        grid = cus * per_cu;
        fprintf(stderr, "kernel_launch: grid %d (cus %d x %d)\n", grid, cus, per_cu);
    }
    if (grid < 0) return;
    Args a{};
    for (int i = 0; i < 31; ++i) a.in[i] = (const float*)d_in[i];
    a.out = (float*)d_out; a.ws = (unsigned char*)d_ws; a.pad = 0;
#if MK_MULTI
    for (int ph = 0; ph < N_RUN; ++ph) { a.ph = ph; hipLaunchKernelGGL(fwd_megakernel, dim3(grid), dim3(NTHREADS), LDS_BYTES, stream, a); }
#else
    a.ph = -1;
    void* kargs[] = {&a};
    hipError_t e = hipLaunchCooperativeKernel((const void*)fwd_megakernel, dim3(grid), dim3(NTHREADS), kargs, LDS_BYTES, stream);
    if (e != hipSuccess) fprintf(stderr, "cooperative launch failed: %s (grid %d)\n", hipGetErrorString(e), grid);
#endif
}
```
